# Optimizing an MI355X kernel written in HIP

```python
import math
import jax, jax.numpy as jnp
from jax import lax
import numpy as np

D_MODEL = 1024
BATCH = 8
SEQ = 2048
DEPTH = 1

CHUNK = 64
Q_BLOCK = 128
ROPE_THETA = 10000.0
LN_EPS = 1e-5

DA_HEADS = 4
DA_V_DIM = D_MODEL // (2 * DA_HEADS)
DA_HEAD_DIM = DA_V_DIM // 2
GLA_HEADS = 4
GLA_V_DIM = D_MODEL // (2 * GLA_HEADS)
GLA_KEY_DIM = GLA_V_DIM // 2
GLA_GATE_RANK = 16
GLA_GATE_NORMALIZER = 16.0

DA_Q = DA_HEADS * 2 * DA_HEAD_DIM
DA_K = DA_HEADS * 2 * DA_HEAD_DIM
DA_V = DA_HEADS * DA_V_DIM
GLA_Q = GLA_HEADS * GLA_KEY_DIM
GLA_K = GLA_HEADS * GLA_KEY_DIM
GLA_V = GLA_HEADS * GLA_V_DIM
GLA_OG = GLA_HEADS * GLA_V_DIM
PROJ_SIZES = (DA_Q, DA_K, DA_V, GLA_Q, GLA_K, GLA_V, GLA_OG, GLA_GATE_RANK)
D_IN = DA_Q + DA_K + DA_V + GLA_Q + GLA_K + GLA_V + GLA_OG + GLA_GATE_RANK
MIX_WIDTH = DA_HEADS * DA_V_DIM + GLA_HEADS * GLA_V_DIM

N_GROUPS = 4
EXPERTS_PER_GROUP = 8
N_EXPERTS = N_GROUPS * EXPERTS_PER_GROUP
TOP_K = 2
D_EXPERT = D_MODEL // 2
MOE_BLOCK = 128

DEEPNORM_ALPHA = (2 * DEPTH) ** 0.25
DEEPNORM_BETA = (8 * DEPTH) ** -0.25

kernel_name = "hybrid_diffattn_gla_hiermoe_deepnorm"


def layer_norm(x, g, b):
    xf = x.astype(jnp.float32)
    mu = jnp.mean(xf, -1, keepdims=True)
    var = jnp.mean(jnp.square(xf - mu), -1, keepdims=True)
    return ((xf - mu) * lax.rsqrt(var + LN_EPS) * g + b).astype(x.dtype)


def rms_norm(x, g):
    xf = x.astype(jnp.float32)
    return (xf * lax.rsqrt(jnp.mean(jnp.square(xf), -1, keepdims=True) + LN_EPS) * g).astype(x.dtype)


def rope_tables(positions, dim):
    inv_freq = ROPE_THETA ** (-jnp.arange(0, dim, 2, dtype=jnp.float32) / dim)
    ang = positions.astype(jnp.float32)[..., None] * inv_freq
    return jnp.cos(ang)[:, :, None, :], jnp.sin(ang)[:, :, None, :]


def apply_rope(t, cos, sin):
    t2 = t.reshape(*t.shape[:-1], -1, 2)
    te, to = t2[..., 0], t2[..., 1]
    c, s = cos.astype(t.dtype), sin.astype(t.dtype)
    return jnp.stack([te * c - to * s, te * s + to * c], -1).reshape(t.shape)


def diff_attention(q, k, v, lam):
    B, H2, S, dh = q.shape
    H = H2 // 2
    n_blk = S // Q_BLOCK
    qb = q.reshape(B, H2, n_blk, Q_BLOCK, dh).transpose(2, 0, 1, 3, 4)
    key_chunk = jnp.arange(S) // CHUNK
    scale = dh ** -0.5

    def one_block(args):
        qi, bi = args
        s = jnp.einsum('bhqd,bhkd->bhqk', qi, k).astype(jnp.float32) * scale
        q_chunk = (bi * Q_BLOCK + jnp.arange(Q_BLOCK)) // CHUNK
        mask = key_chunk[None, :] <= q_chunk[:, None]
        p = jax.nn.softmax(jnp.where(mask, s, -jnp.inf), -1).reshape(B, H, 2, Q_BLOCK, S)
        a = p[:, :, 0] - lam * p[:, :, 1]
        return jnp.einsum('bhqk,bhkd->bhqd', a.astype(v.dtype), v)

    o = lax.map(one_block, (qb, jnp.arange(n_blk)))
    return o.transpose(1, 2, 0, 3, 4).reshape(B, H, S, v.shape[-1])


def gla_chunked(q, k, v, log_a):
    B, S, H, dk = q.shape
    dv = v.shape[-1]
    N = S // CHUNK

    def chunks(t):
        return t.astype(jnp.float32).reshape(B, N, CHUNK, H, t.shape[-1]).transpose(0, 3, 1, 2, 4)

    qc = chunks(q) * dk ** -0.5
    kc, vc, gc = chunks(k), chunks(v), chunks(log_a)
    bcum = jnp.cumsum(gc, axis=3)
    b_last = bcum[:, :, :, -1:, :]
    q_t = qc * jnp.exp(bcum)
    k_t = kc * jnp.exp(-bcum)
    k_end = kc * jnp.exp(b_last - bcum)
    causal = jnp.tril(jnp.ones((CHUNK, CHUNK), dtype=bool))
    att = jnp.where(causal, jnp.einsum('bhncd,bhnjd->bhncj', q_t, k_t), 0.0)
    o_intra = jnp.einsum('bhncj,bhnje->bhnce', att, vc)
    d_state = jnp.einsum('bhncd,bhnce->bhnde', k_end, vc)
    decay = jnp.exp(b_last[:, :, :, 0, :])

    def step(state, inp):
        d_n, ds_n = inp
        return d_n[..., None] * state + ds_n, state

    s0 = jnp.zeros((B, H, dk, dv), jnp.float32)
    _, s_prev = lax.scan(step, s0, (decay.transpose(2, 0, 1, 3), d_state.transpose(2, 0, 1, 3, 4)))
    o_inter = jnp.einsum('bhncd,nbhde->bhnce', q_t, s_prev)
    o = (o_intra + o_inter).transpose(0, 2, 3, 1, 4).reshape(B, S, H, dv)
    return o.astype(v.dtype)


def token_mixer(xn, cos, sin, layer_idx, w_in, lam_q1, lam_k1, lam_q2, lam_k2, da_subln_g,
                gla_w_gate2, gla_b_gate2, gla_norm_g, w_o):
    B, S, _ = xn.shape
    proj = xn @ w_in
    splits = [int(i) for i in np.cumsum(PROJ_SIZES)[:-1]]
    dq, dk_, dv, gq, gk, gv, g_out, g_low = jnp.split(proj, splits, axis=-1)

    dq = apply_rope(dq.reshape(B, S, 2 * DA_HEADS, DA_HEAD_DIM), cos, sin).transpose(0, 2, 1, 3)
    dk_ = apply_rope(dk_.reshape(B, S, 2 * DA_HEADS, DA_HEAD_DIM), cos, sin).transpose(0, 2, 1, 3)
    dv = dv.reshape(B, S, DA_HEADS, DA_V_DIM).transpose(0, 2, 1, 3)
    lam_init = 0.8 - 0.6 * math.exp(-0.3 * layer_idx)
    lam = (jnp.exp(jnp.sum(lam_q1.astype(jnp.float32) * lam_k1))
           - jnp.exp(jnp.sum(lam_q2.astype(jnp.float32) * lam_k2)) + lam_init)
    da = diff_attention(dq, dk_, dv, lam).transpose(0, 2, 1, 3)
    da = (rms_norm(da, da_subln_g) * (1.0 - lam_init)).reshape(B, S, DA_HEADS * DA_V_DIM)

    log_a = jax.nn.log_sigmoid((g_low @ gla_w_gate2 + gla_b_gate2).astype(jnp.float32)) / GLA_GATE_NORMALIZER
    o = gla_chunked(gq.reshape(B, S, GLA_HEADS, GLA_KEY_DIM),
                    gk.reshape(B, S, GLA_HEADS, GLA_KEY_DIM),
                    gv.reshape(B, S, GLA_HEADS, GLA_V_DIM),
                    log_a.reshape(B, S, GLA_HEADS, GLA_KEY_DIM))
    o = rms_norm(o, gla_norm_g).reshape(B, S, GLA_HEADS * GLA_V_DIM) * jax.nn.silu(g_out)

    return jnp.concatenate([da, o], axis=-1) @ w_o


def hier_moe(h, w_rg, b_rg, w_re, b_re, w_gate, w_up, w_down):
    B, S, D = h.shape
    T = B * S
    xt = h.reshape(T, D)
    tok = jnp.arange(T)
    g_logits = (xt @ w_rg).astype(jnp.float32) + b_rg
    g_prob = jax.nn.softmax(g_logits, -1)
    g_top = jnp.argmax(g_logits, -1)
    p_g = g_prob[tok, g_top]
    e_logits = ((xt @ w_re).astype(jnp.float32) + b_re).reshape(T, N_GROUPS, EXPERTS_PER_GROUP)
    e_in = e_logits[tok, g_top]
    top_v, top_i = lax.top_k(e_in, TOP_K)
    gate = jax.nn.softmax(top_v, -1) * p_g[:, None]
    eid = g_top[:, None] * EXPERTS_PER_GROUP + top_i

    flat_e = eid.reshape(-1)
    flat_w = gate.reshape(-1)
    flat_tok = jnp.repeat(tok, TOP_K)
    order = jnp.argsort(flat_e)
    s_e, s_tok, s_w = flat_e[order], flat_tok[order], flat_w[order]
    counts = jnp.bincount(flat_e, length=N_EXPERTS)
    starts = jnp.cumsum(counts) - counts
    padded = ((counts + MOE_BLOCK - 1) // MOE_BLOCK) * MOE_BLOCK
    pad_ends = jnp.cumsum(padded)
    pad_starts = pad_ends - padded
    dest = pad_starts[s_e] + (jnp.arange(T * TOP_K) - starts[s_e])
    n_rows = T * TOP_K + N_EXPERTS * MOE_BLOCK
    n_blocks = n_rows // MOE_BLOCK
    row_tok = jnp.full((n_rows,), T, jnp.int32).at[dest].set(s_tok.astype(jnp.int32))
    x_ext = jnp.concatenate([xt, jnp.zeros((1, D), xt.dtype)], axis=0)
    x_rows = x_ext[row_tok].reshape(n_blocks, MOE_BLOCK, D)
    blk_e = jnp.minimum(jnp.searchsorted(pad_ends, jnp.arange(n_blocks) * MOE_BLOCK, side='right'),
                        N_EXPERTS - 1)

    def expert_block(args):
        xb, e = args
        return (jax.nn.silu(xb @ w_gate[e]) * (xb @ w_up[e])) @ w_down[e]

    y_rows = lax.map(expert_block, (x_rows, blk_e)).reshape(n_rows, D)
    y = jnp.zeros((T, D), xt.dtype).at[s_tok].add(y_rows[dest] * s_w[:, None].astype(xt.dtype))
    return y.reshape(B, S, D)


def setup_inputs(seed: int = 0) -> dict:
    key = jax.random.key(seed)
    ks = jax.random.split(key, 26)
    f32 = jnp.float32
    nrm = lambda k, shape, s: jax.random.normal(k, shape, f32) * s
    x = jax.random.normal(ks[0], (BATCH, SEQ, D_MODEL), f32)
    offsets = jax.random.randint(ks[1], (BATCH, 1), 0, 256) * CHUNK
    positions = (offsets + jnp.arange(SEQ)[None, :]).astype(jnp.int32)
    col_scale = jnp.concatenate([
        jnp.full((n,), s, f32) for n, s in zip(
            PROJ_SIZES, (1.0, 1.0, DEEPNORM_BETA, 1.0, 1.0, DEEPNORM_BETA, 1.0, 1.0))])
    w_in = nrm(ks[2], (DEPTH, D_MODEL, D_IN), D_MODEL ** -0.5) * col_scale
    return {
        "x": x,
        "positions": positions,
        "ln_in_g": 1.0 + nrm(ks[3], (D_MODEL,), 0.02),
        "ln_in_b": nrm(ks[4], (D_MODEL,), 0.02),
        "w_in": w_in,
        "lam_q1": nrm(ks[5], (DEPTH, DA_HEAD_DIM), 0.1),
        "lam_k1": nrm(ks[6], (DEPTH, DA_HEAD_DIM), 0.1),
        "lam_q2": nrm(ks[7], (DEPTH, DA_HEAD_DIM), 0.1),
        "lam_k2": nrm(ks[8], (DEPTH, DA_HEAD_DIM), 0.1),
        "da_subln_g": 1.0 + nrm(ks[9], (DEPTH, DA_V_DIM), 0.02),
        "gla_w_gate2": nrm(ks[10], (DEPTH, GLA_GATE_RANK, GLA_HEADS * GLA_KEY_DIM), GLA_GATE_RANK ** -0.5),
        "gla_b_gate2": nrm(ks[11], (DEPTH, GLA_HEADS * GLA_KEY_DIM), 0.1),
        "gla_norm_g": 1.0 + nrm(ks[12], (DEPTH, GLA_V_DIM), 0.02),
        "w_o": nrm(ks[13], (DEPTH, MIX_WIDTH, D_MODEL), MIX_WIDTH ** -0.5 * DEEPNORM_BETA),
        "ln1_g": 1.0 + nrm(ks[14], (DEPTH, D_MODEL), 0.02),
        "ln1_b": nrm(ks[15], (DEPTH, D_MODEL), 0.02),
        "router_w_group": nrm(ks[16], (DEPTH, D_MODEL, N_GROUPS), D_MODEL ** -0.5),
        "router_b_group": nrm(ks[17], (DEPTH, N_GROUPS), 0.01),
        "router_w_expert": nrm(ks[18], (DEPTH, D_MODEL, N_EXPERTS), D_MODEL ** -0.5),
        "router_b_expert": nrm(ks[19], (DEPTH, N_EXPERTS), 0.01),
        "w_gate": nrm(ks[20], (DEPTH, N_EXPERTS, D_MODEL, D_EXPERT), D_MODEL ** -0.5),
        "w_up": nrm(ks[21], (DEPTH, N_EXPERTS, D_MODEL, D_EXPERT), D_MODEL ** -0.5),
        "w_down": nrm(ks[22], (DEPTH, N_EXPERTS, D_EXPERT, D_MODEL), D_EXPERT ** -0.5 * DEEPNORM_BETA),
        "ln2_g": 1.0 + nrm(ks[23], (DEPTH, D_MODEL), 0.02),
        "ln2_b": nrm(ks[24], (DEPTH, D_MODEL), 0.02),
    }


def reference(x, positions, ln_in_g, ln_in_b, w_in, lam_q1, lam_k1, lam_q2, lam_k2, da_subln_g,
              gla_w_gate2, gla_b_gate2, gla_norm_g, w_o, ln1_g, ln1_b, router_w_group,
              router_b_group, router_w_expert, router_b_expert, w_gate, w_up, w_down,
              ln2_g, ln2_b):
    cos, sin = rope_tables(positions, DA_HEAD_DIM)
    x = layer_norm(x, ln_in_g, ln_in_b)
    for l in range(DEPTH):
        mix = token_mixer(x, cos, sin, l, w_in[l], lam_q1[l], lam_k1[l], lam_q2[l], lam_k2[l],
                          da_subln_g[l], gla_w_gate2[l], gla_b_gate2[l], gla_norm_g[l], w_o[l])
        h = layer_norm(DEEPNORM_ALPHA * x + mix, ln1_g[l], ln1_b[l])
        ffn = hier_moe(h, router_w_group[l], router_b_group[l], router_w_expert[l],
                       router_b_expert[l], w_gate[l], w_up[l], w_down[l])
        x = layer_norm(DEEPNORM_ALPHA * h + ffn, ln2_g[l], ln2_b[l])
    return x
```

```cpp
#include <hip/hip_runtime.h>
#include <cstdio>
#include <cstdint>

#ifndef MK_SPLIT
#define MK_SPLIT 0
#endif

#define GAS __attribute__((address_space(1)))
#define LAS __attribute__((address_space(3)))
typedef unsigned short bf16;
typedef unsigned v4u __attribute__((ext_vector_type(4)));
typedef unsigned v2u __attribute__((ext_vector_type(2)));
typedef float f32x4 __attribute__((ext_vector_type(4)));
typedef float f32x2 __attribute__((ext_vector_type(2)));
typedef float f32x16 __attribute__((ext_vector_type(16)));
typedef short bf16x8 __attribute__((ext_vector_type(8)));
typedef short s16x4 __attribute__((ext_vector_type(4)));
typedef short v4i16_t __attribute__((ext_vector_type(4)));

constexpr int T = 16384, D = 1024, NB = 8, SEQ = 2048;
constexpr int NPROJ = 3072;
constexpr int WIN_LD = 3088;
constexpr int C_DQ = 0, C_GO = 512, C_DK = 1024, C_DV = 1536, C_GQ = 2048, C_GK = 2304, C_GV = 2560;
constexpr int NEXP = 32, DE = 512, LCAP = 16384;
constexpr float LN_EPS = 1e-5f;
constexpr float ALPHA = 1.189207115002721f;
constexpr float C2 = 0.125f * 1.4426950408889634f;
constexpr float LAM_INIT = 0.2f;

constexpr size_t MiB = 1u << 20;
constexpr size_t WS_CTL = 0, CTL_ZERO_BYTES = 1 * MiB;
constexpr size_t WS_STATS = 1 * MiB;
constexpr size_t WS_GLOW = 2 * MiB;
constexpr size_t WS_ROPE = 4 * MiB;
constexpr size_t WS_LTOK = 8 * MiB;
constexpr size_t WS_LW = 10 * MiB;
constexpr size_t WS_DEC = 12 * MiB;
constexpr size_t WS_WRT = 13 * MiB;
constexpr size_t WS_WIN = 16 * MiB;
constexpr size_t WS_WO = 22 * MiB;
constexpr size_t WS_WGU = 24 * MiB;
constexpr size_t WS_WD = 88 * MiB;
constexpr size_t WS_A = 120 * MiB;
constexpr size_t WS_HB = WS_A, WS_Y = WS_A + 32 * MiB;
constexpr size_t WS_B = 216 * MiB;
constexpr size_t WS_DS = WS_B, WS_SP = WS_B + 16 * MiB;
constexpr size_t WS_END = 256 * MiB;
constexpr int CW_TMO = 0, CW_BAR = 4096, CW_CNT = 8192;

constexpr int SCR_BYTES = 153600;
constexpr int LDSCTL_OFF = SCR_BYTES;
constexpr int LDS_BYTES = SCR_BYTES + 1024;

#define RLX_AGENT __ATOMIC_RELAXED, __HIP_MEMORY_SCOPE_AGENT
#define LDS_WAIT() asm volatile("s_waitcnt lgkmcnt(0)" ::: "memory")
#define VM_WAIT() asm volatile("s_waitcnt vmcnt(0)" ::: "memory")
typedef __bf16 bf16x2_t __attribute__((ext_vector_type(2)));
__device__ __forceinline__ unsigned cvt_pk_bf16(float lo, float hi) { const f32x2 v = {lo, hi}; const bf16x2_t b = __builtin_convertvector(v, bf16x2_t); return __builtin_bit_cast(unsigned, b); }
__device__ __forceinline__ float bf_lo(unsigned u) { return __uint_as_float(u << 16); }
__device__ __forceinline__ float bf_hi(unsigned u) { return __uint_as_float(u & 0xffff0000u); }
__device__ __forceinline__ float wave_sum(float v) {
#pragma unroll
    for (int o = 1; o < 64; o <<= 1) v += __shfl_xor(v, o);
    return v;
}
__device__ __forceinline__ float ex2(float x) { return __builtin_amdgcn_exp2f(x); }
__device__ __forceinline__ int crow(int r, int hi) { return (r & 3) + 8 * (r >> 2) + 4 * hi; }
template <int N> __device__ __forceinline__ void reduce_scatter(float (&v)[N], int lane) {
    int off = 32;
#pragma unroll
    for (int n = N; n > 1; n >>= 1) {
        const int half = n >> 1; const bool up = (lane & off) != 0;
#pragma unroll
        for (int i = 0; i < half; ++i) { const float send = up ? v[i] : v[i + half]; const float keep = up ? v[i + half] : v[i]; v[i] = keep + __shfl_xor(send, off); }
        off >>= 1;
    }
    for (; off >= 1; off >>= 1) v[0] += __shfl_xor(v[0], off);
}

namespace pg8 {
constexpr int BM = 256, BK = 64, HALF = 128, HTB = HALF * BK * 2, STAGE_BYTES = 8 * HTB, NXCD = 8, WGM = 8;
__host__ __device__ __forceinline__ int lds_byte(int r, int c) { const int st = (r >> 4) * 2 + (c >> 5), rr = r & 15, cc = c & 31, ob = rr * 64 + cc * 2; return st * 1024 + (ob ^ (((ob >> 9) & 1) << 5)); }
__host__ __device__ __forceinline__ void stage_rc(int b, int& R, int& C) { const int st = b / 1024, sb = b % 1024, swz = sb ^ (((sb >> 9) & 1) << 5); R = (st >> 1) * 16 + swz / 64; C = (st & 1) * 32 + (swz % 64) / 2; }
__host__ __device__ __forceinline__ int perm32(int rho) { const int n = rho >> 4, i = rho & 15; return 8 * (i >> 2) + 4 * n + (i & 3); }

struct Unit { const char* A; const char* B; unsigned va00, va01, va10, va11; int pm, pn, e, r0, cnt; };

template <class Epi, class Sched, bool ALIGN_EPI>
__device__ __forceinline__ void gemm_phase(LAS unsigned char* lds, const int K, const Sched& S, const Epi& E) {
    const int tid = threadIdx.x, wid = __builtin_amdgcn_readfirstlane(tid >> 6), lane = tid & 63, wr = wid >> 2, wc = wid & 3, fr = lane & 15, fq = lane >> 4;
    const int nt = K / BK;
    unsigned voffB[2];
#pragma unroll
    for (int i = 0; i < 2; ++i) { int R, C; stage_rc(tid * 16 + i * 8192, R, C); const int Rb = Epi::PERM ? ((R & ~31) + perm32(R & 31)) : R; voffB[i] = (unsigned)(Rb * K + C) * 2u; }
    const size_t kstep = (size_t)(BK * 2);
    const size_t hstep = (size_t)HALF * K * 2;
    const unsigned ldsw = (unsigned)wid * 1024u;
    const int aoff = lds_byte(wr * 64 + fr, fq * 8), boff = lds_byte(wc * 32 + fr, fq * 8);
#define PG8_SA(b, h) (((b) * 2 + (h)) * HTB)
#define PG8_SB(b, h) ((4 + (b) * 2 + (h)) * HTB)
#define PG8_STAGE2(bufoff, gbase, v0, v1) do { \
        __builtin_amdgcn_global_load_lds((const unsigned*)((const char*)(gbase) + (v0)), (LAS unsigned*)(lds + (bufoff) + ldsw), 16, 0, 0); \
        __builtin_amdgcn_global_load_lds((const unsigned*)((const char*)(gbase) + (v1)), (LAS unsigned*)(lds + (bufoff) + ldsw + 8192), 16, 0, 0); } while (0)
#define PG8_STAGE(bufoff, gbase, voff) PG8_STAGE2(bufoff, gbase, (voff)[0], (voff)[1])
#define PG8_LDA(dst, b, h) do { _Pragma("unroll") for (int m = 0; m < 4; ++m) _Pragma("unroll") for (int k = 0; k < 2; ++k) dst[m][k] = *(const LAS bf16x8*)(lds + PG8_SA(b, h) + aoff + m * 2048 + k * 1024); } while (0)
#define PG8_LDB(dst, b, h) do { _Pragma("unroll") for (int n = 0; n < 2; ++n) _Pragma("unroll") for (int k = 0; k < 2; ++k) dst[n][k] = *(const LAS bf16x8*)(lds + PG8_SB(b, h) + boff + n * 2048 + k * 1024); } while (0)
#define PG8_MMA(ai, bj, At, Bt) do { __builtin_amdgcn_s_setprio(1); _Pragma("unroll") for (int m = 0; m < 4; ++m) _Pragma("unroll") for (int n = 0; n < 2; ++n) _Pragma("unroll") for (int k = 0; k < 2; ++k) \
        acc[ai][bj][m][n] = __builtin_amdgcn_mfma_f32_16x16x32_bf16(Bt[n][k], At[m][k], acc[ai][bj][m][n], 0, 0, 0); __builtin_amdgcn_s_setprio(0); } while (0)
#define PG8_WAIT_V(n) asm volatile("s_waitcnt vmcnt(" #n ")" ::: "memory")
#define PG8_WAIT_L(n) asm volatile("s_waitcnt lgkmcnt(" #n ")" ::: "memory")
#define PG8_BAR __builtin_amdgcn_s_barrier()
#define PG8_SCHED __builtin_amdgcn_sched_barrier(0)
    Unit cur, nxt; int ui = 0;
    if (!S.next(0, cur)) return;
    f32x4 acc[2][2][4][2];
#pragma unroll
    for (int a = 0; a < 2; ++a)
#pragma unroll
        for (int b = 0; b < 2; ++b)
#pragma unroll
            for (int m = 0; m < 4; ++m)
#pragma unroll
                for (int n = 0; n < 2; ++n) acc[a][b][m][n] = (f32x4){0.f, 0.f, 0.f, 0.f};
    bf16x8 At[4][2], B0[2][2], B1[2][2];
    const char* cA = cur.A; const char* cB = cur.B;
    PG8_STAGE(PG8_SB(0, 0), cB, voffB); PG8_STAGE(PG8_SB(0, 1), cB + hstep, voffB); PG8_STAGE2(PG8_SA(0, 0), cA, cur.va00, cur.va01); PG8_STAGE2(PG8_SA(0, 1), cA, cur.va10, cur.va11);
    if (wr == 1) PG8_BAR;
    PG8_WAIT_V(2); PG8_BAR;
    PG8_STAGE(PG8_SB(1, 0), cB + kstep, voffB); PG8_STAGE2(PG8_SA(1, 0), cA + kstep, cur.va00, cur.va01); PG8_STAGE(PG8_SB(1, 1), cB + hstep + kstep, voffB);
    PG8_WAIT_V(6); PG8_BAR;
    for (;;) {
        const bool has_next = S.next(ui + 1, nxt);
        const char* nA = has_next ? nxt.A : cA; const char* nB = has_next ? nxt.B : cB;
        const unsigned n00 = has_next ? nxt.va00 : cur.va00, n01 = has_next ? nxt.va01 : cur.va01, n10 = has_next ? nxt.va10 : cur.va10, n11 = has_next ? nxt.va11 : cur.va11;
        for (int t = 0; t < nt; t += 2) {
            const bool last = (t == nt - 2);
            const char* a1 = cA + (size_t)(t + 1) * kstep;
            const char* a2 = last ? nA : cA + (size_t)(t + 2) * kstep; const char* b2 = last ? nB : cB + (size_t)(t + 2) * kstep;
            const char* a3 = a2 + kstep; const char* b3 = b2 + kstep;
            const unsigned w00 = last ? n00 : cur.va00, w01 = last ? n01 : cur.va01, w10 = last ? n10 : cur.va10, w11 = last ? n11 : cur.va11;
            PG8_LDB(B0, 0, 0); PG8_LDB(B1, 0, 1); PG8_SCHED; PG8_LDA(At, 0, 0); PG8_STAGE2(PG8_SA(1, 1), a1, cur.va10, cur.va11);
            PG8_WAIT_V(8); PG8_WAIT_L(0); PG8_BAR; PG8_MMA(0, 0, At, B0); PG8_MMA(0, 1, At, B1); PG8_BAR; PG8_SCHED;
            PG8_LDA(At, 0, 1); PG8_STAGE(PG8_SB(0, 0), b2, voffB); PG8_STAGE(PG8_SB(0, 1), b2 + hstep, voffB); PG8_STAGE2(PG8_SA(0, 0), a2, w00, w01);
            PG8_WAIT_V(8); PG8_WAIT_L(0); PG8_BAR; PG8_MMA(1, 0, At, B0); PG8_MMA(1, 1, At, B1); PG8_BAR; PG8_SCHED;
            PG8_LDB(B0, 1, 0); PG8_LDB(B1, 1, 1); PG8_SCHED; PG8_LDA(At, 1, 0); PG8_STAGE2(PG8_SA(0, 1), a2, w10, w11);
            PG8_WAIT_V(8); PG8_WAIT_L(0); PG8_BAR; PG8_MMA(0, 0, At, B0); PG8_MMA(0, 1, At, B1); PG8_BAR; PG8_SCHED;
            PG8_LDA(At, 1, 1); PG8_STAGE(PG8_SB(1, 0), b3, voffB); PG8_STAGE(PG8_SB(1, 1), b3 + hstep, voffB); PG8_STAGE2(PG8_SA(1, 0), a3, w00, w01);
            PG8_WAIT_V(8); PG8_WAIT_L(0); PG8_BAR; PG8_MMA(1, 0, At, B0); PG8_MMA(1, 1, At, B1); PG8_BAR; PG8_SCHED;
        }
        if constexpr (ALIGN_EPI) { if (wr == 0) PG8_BAR; }
        E(acc, cur, wr, wc, fr, fq);
        if (!has_next) break;
#pragma unroll
        for (int a = 0; a < 2; ++a)
#pragma unroll
            for (int b = 0; b < 2; ++b)
#pragma unroll
                for (int m = 0; m < 4; ++m)
#pragma unroll
                    for (int n = 0; n < 2; ++n) acc[a][b][m][n] = (f32x4){0.f, 0.f, 0.f, 0.f};
        cur = nxt; cA = nA; cB = nB; ++ui;
        if constexpr (ALIGN_EPI) { if (wr == 1) PG8_BAR; }
    }
    PG8_WAIT_V(0);
    if constexpr (!ALIGN_EPI) { if (wr == 0) PG8_BAR; }
    PG8_BAR;
#undef PG8_SA
#undef PG8_SB
#undef PG8_STAGE
#undef PG8_STAGE2
#undef PG8_LDA
#undef PG8_LDB
#undef PG8_MMA
#undef PG8_WAIT_V
#undef PG8_WAIT_L
#undef PG8_BAR
#undef PG8_SCHED
}

struct DenseOrder {
    const char* A; const char* B; int lda, K, nM, nN, nwg, G, c;
    __device__ __forceinline__ void init(const void* A_, int lda_, const void* B_, int K_, int M, int N, int G_, int c_) { A = (const char*)A_; B = (const char*)B_; lda = lda_; K = K_; nM = M / BM; nN = N / BM; nwg = nM * nN; G = G_; c = c_; }
    __device__ __forceinline__ bool next(int i, Unit& u) const {
        const long L = (long)i * G + c; if (L >= nwg) return false;
        int wgid = (int)L; { const int q = nwg / NXCD, r = nwg % NXCD, xcd = wgid % NXCD, off = wgid / NXCD; wgid = (xcd < r ? xcd * (q + 1) : r * (q + 1) + (xcd - r) * q) + off; }
        const int nig = WGM * nN, gid = wgid / nig, fm = gid * WGM, gsz = (nM - fm) < WGM ? (nM - fm) : WGM;
        u.pm = fm + ((wgid % nig) % gsz); u.pn = (wgid % nig) / gsz; u.e = 0; u.r0 = 0; u.cnt = 0;
        u.A = A + (size_t)u.pm * BM * lda * 2; u.B = B + (size_t)u.pn * BM * K * 2;
        const int tid = threadIdx.x; int R0, C0, R1, C1; stage_rc(tid * 16, R0, C0); stage_rc(tid * 16 + 8192, R1, C1);
        u.va00 = (unsigned)(R0 * lda + C0) * 2u; u.va01 = (unsigned)(R1 * lda + C1) * 2u; u.va10 = (unsigned)((HALF + R0) * lda + C0) * 2u; u.va11 = (unsigned)((HALF + R1) * lda + C1) * 2u;
        return true;
    }
};
}

#define XB_TMO      128
#define XB_XCNT(j)  (256  + 64 * (j))
#define XB_XSUB(j)  (1280 + 64 * (j))
#define XB_XGEN(j)  (2304 + 64 * (j))
#define XB_TOP      3328
#define XB_TOPGEN   3392
#define XCD_BAR_WORDS 3456
#define XB_SPIN_CAP (1u << 18)
__device__ __forceinline__ unsigned xb_ld(unsigned* p)              { return __hip_atomic_load(p, __ATOMIC_RELAXED, __HIP_MEMORY_SCOPE_AGENT); }
__device__ __forceinline__ unsigned xb_add(unsigned* p, unsigned v) { return __hip_atomic_fetch_add(p, v, __ATOMIC_RELAXED, __HIP_MEMORY_SCOPE_AGENT); }
__device__ __forceinline__ unsigned xb_xcc_id() { return (unsigned)__builtin_amdgcn_s_getreg((3 << 11) | 20) & 0xFu; }
#define XB_SPIN(cond, bar) do { unsigned _sp = 0; while (cond) { __builtin_amdgcn_s_sleep(1); \
    if ((++_sp & 255u) == 0u) { if (xb_ld(&(bar)[XB_TMO])) break; if (_sp > XB_SPIN_CAP) { atomicAdd(&(bar)[XB_TMO], 1u); break; } } } } while (0)
struct XcdBarrier { unsigned* bar; unsigned x; volatile LAS unsigned* st; };
__device__ __forceinline__ XcdBarrier xcd_barrier_post(unsigned* bar, volatile LAS unsigned* st) {
    XcdBarrier b; b.bar = bar; b.x = xb_xcc_id(); b.st = st;
    if (threadIdx.x == 0) (void)xb_add(&bar[XB_XCNT(b.x)], 1u);
    return b;
}
__device__ __forceinline__ void xcd_barrier_complete(unsigned* bar, unsigned x, unsigned& nloc, unsigned& nx) {
    const unsigned G = gridDim.x * gridDim.y * gridDim.z;
    unsigned sum, cnt, mine, sp = 0u;
    for (;;) {
        sum = 0u; cnt = 0u; mine = 0u;
#pragma unroll
        for (unsigned j = 0; j < 16; ++j) { const unsigned c = xb_ld(&bar[XB_XCNT(j)]); sum += c; cnt += (c > 0u) ? 1u : 0u; mine = (j == x) ? c : mine; }
        if (sum == G) break;
        __builtin_amdgcn_s_sleep(1);
        if ((++sp & 255u) == 0u) { if (xb_ld(&bar[XB_TMO])) break; if (sp > XB_SPIN_CAP) { atomicAdd(&bar[XB_TMO], 1u); break; } }
    }
    nloc = mine > 0u ? mine : 1u; nx = cnt > 0u ? cnt : 1u;
}
__device__ __forceinline__ void xcd_barrier(const XcdBarrier& b) {
    asm volatile("s_waitcnt vmcnt(0)" ::: "memory");
    __syncthreads();
    if (threadIdx.x == 0) {
        unsigned* bar = b.bar;
        __builtin_amdgcn_s_waitcnt(0);
        unsigned nloc = b.st[0], nx = b.st[1];
        if (nloc == 0u) { xcd_barrier_complete(bar, b.x, nloc, nx); b.st[0] = nloc; b.st[1] = nx; }
        const unsigned old = xb_add(&bar[XB_XSUB(b.x)], 1u);
        const unsigned gen = old / nloc;
        if (old + 1u == (gen + 1u) * nloc) {
            __builtin_amdgcn_fence(__ATOMIC_RELEASE, "agent");
            asm volatile("s_waitcnt vmcnt(0)" ::: "memory");
            const unsigned og = xb_add(&bar[XB_TOP], 1u);
            const unsigned tg = og / nx;
            if (og + 1u == (tg + 1u) * nx) xb_add(&bar[XB_TOPGEN], 1u);
            else XB_SPIN(xb_ld(&bar[XB_TOPGEN]) == tg, bar);
            __builtin_amdgcn_fence(__ATOMIC_ACQUIRE, "agent");
            xb_add(&bar[XB_XGEN(b.x)], 1u);
            asm volatile("s_waitcnt vmcnt(0)" ::: "memory");
        } else {
            XB_SPIN(xb_ld(&bar[XB_XGEN(b.x)]) == gen, bar);
            __builtin_amdgcn_fence(__ATOMIC_ACQUIRE, "agent");
            asm volatile("s_waitcnt vmcnt(0)" ::: "memory");
        }
    }
    __syncthreads();
}

struct Args {
    const float* x; const int* pos; const float* ln_in_g; const float* ln_in_b; const float* w_in;
    const float* lam_q1; const float* lam_k1; const float* lam_q2; const float* lam_k2; const float* subln_g;
    const float* wg2; const float* bg2; const float* gla_norm_g; const float* w_o; const float* ln1_g; const float* ln1_b;
    const float* w_rg; const float* b_rg; const float* w_re; const float* b_re; const float* w_gate; const float* w_up; const float* w_down;
    const float* ln2_g; const float* ln2_b;
    float* out; unsigned char* ws; int ph_lo, ph_hi;
};

struct TItem { const float* src; bf16* dst; int ldw, ldt; };
__device__ __forceinline__ void p0_item_load(const TItem& t, f32x4 (&v)[16], int lane) {
    const float* src = t.src + (size_t)(lane >> 4) * t.ldw + 4 * (lane & 15);
#pragma unroll
    for (int i = 0; i < 16; ++i) v[i] = *(const f32x4*)(src + (size_t)(4 * i) * t.ldw);
}
__device__ __forceinline__ void p0_item_finish(const TItem& t, const f32x4 (&v)[16], LAS float* scr, int lane) {
    LAS float* d = scr + (lane >> 4) * 65 + 4 * (lane & 15);
#pragma unroll
    for (int i = 0; i < 16; ++i) { d[(4 * i) * 65 + 0] = v[i].x; d[(4 * i) * 65 + 1] = v[i].y; d[(4 * i) * 65 + 2] = v[i].z; d[(4 * i) * 65 + 3] = v[i].w; }
    LDS_WAIT(); asm volatile("" ::: "memory");
    const int c = lane & 7;
#pragma unroll
    for (int j = 0; j < 8; ++j) { const int n = (lane >> 3) + 8 * j; const LAS float* s = scr + (8 * c) * 65 + n;
        v4u o; o.x = cvt_pk_bf16(s[0 * 65], s[1 * 65]); o.y = cvt_pk_bf16(s[2 * 65], s[3 * 65]); o.z = cvt_pk_bf16(s[4 * 65], s[5 * 65]); o.w = cvt_pk_bf16(s[6 * 65], s[7 * 65]);
        *(GAS v4u*)(t.dst + (size_t)n * t.ldt + 8 * c) = o; }
    LDS_WAIT(); asm volatile("" ::: "memory");
}
__device__ __forceinline__ TItem p0_item_decode(const Args& a, int it) {
    constexpr int I_IN = 16 * 48, I_O = 16 * 16, I_G = 32 * 128, I_U = 32 * 128;
    unsigned char* ws = a.ws; bf16* WIN = (bf16*)(ws + WS_WIN); bf16* WO = (bf16*)(ws + WS_WO); bf16* WGU = (bf16*)(ws + WS_WGU); bf16* WD = (bf16*)(ws + WS_WD);
    TItem t; int r = it;
    if (r < I_IN) { const int kb = r / 48, nb = r % 48, n0 = 64 * nb, sb = n0 >> 9;
        const int dmap = (sb == 0) ? C_DQ : (sb == 1) ? C_DK : (sb == 2) ? C_DV : (sb == 3) ? C_GQ : (sb == 4) ? C_GV : C_GO;
        t.src = a.w_in + (size_t)(64 * kb) * WIN_LD + n0; t.ldw = WIN_LD; t.dst = WIN + (size_t)(dmap + (n0 & 511)) * 1024 + 64 * kb; t.ldt = 1024; return t; }
    r -= I_IN;
    if (r < I_O) { const int kb = r / 16, nb = r % 16; t.src = a.w_o + (size_t)(64 * kb) * 1024 + 64 * nb; t.ldw = 1024; t.dst = WO + (size_t)(64 * nb) * 1024 + 64 * kb; t.ldt = 1024; return t; }
    r -= I_O;
    if (r < I_G + I_U) { const bool up = r >= I_G; if (up) r -= I_G; const int e = r >> 7, q = r & 127, kb = q >> 3, nb = q & 7, n0 = 64 * nb;
        t.src = (up ? a.w_up : a.w_gate) + (size_t)e * 1024 * 512 + (size_t)(64 * kb) * 512 + n0; t.ldw = 512;
        t.dst = WGU + (size_t)e * 1024 * 1024 + (size_t)(256 * (n0 >> 7) + (n0 & 127) + (up ? 128 : 0)) * 1024 + 64 * kb; t.ldt = 1024; return t; }
    r -= I_G + I_U;
    { const int e = r >> 7, q = r & 127, kb = q >> 4, nb = q & 15;
      t.src = a.w_down + (size_t)e * 512 * 1024 + (size_t)(64 * kb) * 1024 + 64 * nb; t.ldw = 1024; t.dst = WD + (size_t)e * 1024 * 512 + (size_t)(64 * nb) * 512 + 64 * kb; t.ldt = 512; return t; }
}

template <int RT, int RR, int RL>
__device__ __forceinline__ void phase0(const Args& a, LAS unsigned char* lds, int vcu, int G, int tid, int lane, int wave) {
    unsigned char* ws = a.ws;
    LAS float* scr = (LAS float*)(lds + wave * 16640);
    const int gw = vcu * 8 + wave, NGW = G * 8, bx0 = vcu;
    constexpr int NITEMS = 16 * 48 + 16 * 16 + 3 * 32 * 128;
#pragma unroll
    for (int rep = 0; rep < RT; ++rep) {
        f32x4 va[16], vb[16]; TItem ta, tb; int it = gw;
        if (it < NITEMS) { ta = p0_item_decode(a, it); p0_item_load(ta, va, lane); }
        while (it < NITEMS) {
            const int itn = it + NGW;
            if (itn < NITEMS) { tb = p0_item_decode(a, itn); p0_item_load(tb, vb, lane); }
            p0_item_finish(ta, va, scr, lane);
            ta = tb;
#pragma unroll
            for (int i = 0; i < 16; ++i) va[i] = vb[i];
            it = itn;
        }
    }
    __syncthreads();
#pragma unroll
    for (int rep = 0; rep < RR; ++rep) {
        f32x2* rope = (f32x2*)(ws + WS_ROPE);
        for (int idx = (vcu * 512 + tid); idx < T * 32; idx += G * 512) {
            const int tt = idx >> 5, i = idx & 31;
            const float invf = (float)exp(-(double)i * (9.210340371976184 / 32.0));
            const float ang = (float)a.pos[tt] * invf;
            const double ad = (double)ang; const double kq = rint(ad * 0.15915494309189535);
            double r = fma(-kq, 6.283185307179586, ad); r = fma(-kq, 2.4492935982947064e-16, r);
            const double z = r * r;
            double s = 1.0 / 51090942171709440000.0;
            s = fma(s, z, -1.0 / 121645100408832000.0); s = fma(s, z, 1.0 / 355687428096000.0); s = fma(s, z, -1.0 / 1307674368000.0); s = fma(s, z, 1.0 / 6227020800.0);
            s = fma(s, z, -1.0 / 39916800.0); s = fma(s, z, 1.0 / 362880.0); s = fma(s, z, -1.0 / 5040.0); s = fma(s, z, 1.0 / 120.0); s = fma(s, z, -1.0 / 6.0); s = fma(s, z, 1.0);
            s *= r;
            double c = -1.0 / 1124000727777607680000.0;
            c = fma(c, z, 1.0 / 2432902008176640000.0); c = fma(c, z, -1.0 / 6402373705728000.0); c = fma(c, z, 1.0 / 20922789888000.0); c = fma(c, z, -1.0 / 87178291200.0);
            c = fma(c, z, 1.0 / 479001600.0); c = fma(c, z, -1.0 / 3628800.0); c = fma(c, z, 1.0 / 40320.0); c = fma(c, z, -1.0 / 720.0); c = fma(c, z, 1.0 / 24.0); c = fma(c, z, -0.5); c = fma(c, z, 1.0);
            rope[idx] = (f32x2){(float)c, (float)s};
        }
    }
    { bf16* WRT = (bf16*)(ws + WS_WRT);
      for (int idx = vcu * 512 + tid; idx < 48 * 1024; idx += G * 512) { const int c = idx >> 10, k = idx & 1023;
          const float w = (c < 4) ? a.w_rg[k * 4 + c] : (c < 36) ? a.w_re[k * 32 + (c - 4)] : 0.f;
          const unsigned hi = cvt_pk_bf16(w, 0.f) & 0xffffu; const unsigned lo = cvt_pk_bf16(w - bf_lo(hi), 0.f) & 0xffffu;
          WRT[idx] = (bf16)hi; WRT[48 * 1024 + idx] = (bf16)lo; } }
#pragma unroll
    for (int rep = 0; rep < RL; ++rep) {
        bf16* XN = (bf16*)(ws + WS_B); float* stats = (float*)(ws + WS_STATS); float* glow = (float*)(ws + WS_GLOW);
        LAS float* red = (LAS float*)(lds + 33024);
        bf16x8 wf[4];
#pragma unroll
        for (int sk = 0; sk < 4; ++sk) { const float* wp = a.w_in + (size_t)(128 * wave + 32 * sk + 8 * (lane >> 4)) * WIN_LD + NPROJ + (lane & 15);
            v4u w; w.x = cvt_pk_bf16(wp[0], wp[WIN_LD]); w.y = cvt_pk_bf16(wp[2 * WIN_LD], wp[3 * WIN_LD]); w.z = cvt_pk_bf16(wp[4 * WIN_LD], wp[5 * WIN_LD]); w.w = cvt_pk_bf16(wp[6 * WIN_LD], wp[7 * WIN_LD]);
            wf[sk] = __builtin_bit_cast(bf16x8, w); }
        const int ngrp = T / 16;
        f32x4 vn[2][4];
        { const int g0 = bx0; if (g0 < ngrp) {
#pragma unroll
            for (int q = 0; q < 2; ++q) { const GAS f32x4* xr = (const GAS f32x4*)(a.x + ((size_t)g0 * 16 + 2 * wave + q) * D) + lane;
#pragma unroll
                for (int j = 0; j < 4; ++j) vn[q][j] = xr[64 * j]; } } }
        for (int grp = bx0; grp < ngrp; grp += G) {
            f32x4 v[2][4];
#pragma unroll
            for (int q = 0; q < 2; ++q)
#pragma unroll
                for (int j = 0; j < 4; ++j) v[q][j] = vn[q][j];
            if (grp + G < ngrp) {
#pragma unroll
                for (int q = 0; q < 2; ++q) { const GAS f32x4* xr = (const GAS f32x4*)(a.x + ((size_t)(grp + G) * 16 + 2 * wave + q) * D) + lane;
#pragma unroll
                    for (int j = 0; j < 4; ++j) vn[q][j] = xr[64 * j]; } }
#pragma unroll
            for (int q = 0; q < 2; ++q) {
                const int rl = 2 * wave + q; const size_t m = (size_t)grp * 16 + rl;
                float s = 0.f;
#pragma unroll
                for (int j = 0; j < 4; ++j) s += (v[q][j].x + v[q][j].y) + (v[q][j].z + v[q][j].w);
                const float mean = wave_sum(s) * (1.f / D); float s2 = 0.f;
#pragma unroll
                for (int j = 0; j < 4; ++j) { v[q][j] = v[q][j] - mean; s2 += (v[q][j].x * v[q][j].x + v[q][j].y * v[q][j].y) + (v[q][j].z * v[q][j].z + v[q][j].w * v[q][j].w); }
                const float rstd = 1.f / sqrtf(wave_sum(s2) * (1.f / D) + LN_EPS);
                if (lane == 0) *(f32x2*)(stats + 2 * m) = (f32x2){mean, rstd};
                GAS v2u* o8 = (GAS v2u*)(XN + m * D) + lane;
#pragma unroll
                for (int j = 0; j < 4; ++j) {
                    const f32x4 y = v[q][j] * rstd * *(const f32x4*)(a.ln_in_g + 4 * lane + 256 * j) + *(const f32x4*)(a.ln_in_b + 4 * lane + 256 * j);
                    v2u w; w.x = cvt_pk_bf16(y.x, y.y); w.y = cvt_pk_bf16(y.z, y.w); o8[64 * j] = w;
                    *(LAS v2u*)(lds + rl * 2064 + (4 * lane + 256 * j) * 2) = w;
                }
            }
            __syncthreads();
            { f32x4 acc = (f32x4){0.f, 0.f, 0.f, 0.f};
#pragma unroll
              for (int sk = 0; sk < 4; ++sk) { const bf16x8 af = *(const LAS bf16x8*)(lds + (lane & 15) * 2064 + (128 * wave + 32 * sk + 8 * (lane >> 4)) * 2);
                  acc = __builtin_amdgcn_mfma_f32_16x16x32_bf16(af, wf[sk], acc, 0, 0, 0); }
#pragma unroll
              for (int r = 0; r < 4; ++r) red[(wave * 4 + r) * 64 + lane] = acc[r]; }
            __syncthreads();
            if (tid < 256) { const int row = tid >> 4, col = tid & 15, ls = col + 16 * (row >> 2), r = row & 3; float sum = 0.f;
#pragma unroll
                for (int w = 0; w < 8; ++w) sum += red[(w * 4 + r) * 64 + ls];
                glow[((size_t)grp * 16 + row) * 16 + col] = sum; }
        }
        __syncthreads();
    }
}

struct EpiProj {
    static constexpr bool PERM = true;
    bf16* O; const float* rope;
    __device__ __forceinline__ void operator()(const f32x4 (&acc)[2][2][4][2], const pg8::Unit& u, int wr, int wc, int fr, int fq) const {
        const int pn = u.pn; const bool dorope = (pn < 2) || (pn == 4) || (pn == 5); const float sc = (pn < 2) ? C2 : 1.f;
        const int row0 = u.pm * 256 + wr * 64 + fr, col0 = pn * 256 + wc * 32 + 8 * fq;
        const int i0 = 16 * (wc & 1) + 4 * fq;
#pragma unroll
        for (int ai = 0; ai < 2; ++ai)
#pragma unroll
            for (int m = 0; m < 4; ++m) {
                const int row = row0 + ai * 128 + m * 16;
                f32x4 cs0 = (f32x4){1.f, 0.f, 1.f, 0.f}, cs1 = cs0;
                if (dorope) { const f32x4* rp = (const f32x4*)(rope + ((size_t)row * 32 + i0) * 2); cs0 = rp[0]; cs1 = rp[1]; }
#pragma unroll
                for (int bj = 0; bj < 2; ++bj) {
                    const f32x4 v0 = acc[ai][bj][m][0], v1 = acc[ai][bj][m][1];
                    float o0 = v0[0] * cs0[0] - v0[1] * cs0[1], o1 = v0[0] * cs0[1] + v0[1] * cs0[0];
                    float o2 = v0[2] * cs0[2] - v0[3] * cs0[3], o3 = v0[2] * cs0[3] + v0[3] * cs0[2];
                    float o4 = v1[0] * cs1[0] - v1[1] * cs1[1], o5 = v1[0] * cs1[1] + v1[1] * cs1[0];
                    float o6 = v1[2] * cs1[2] - v1[3] * cs1[3], o7 = v1[2] * cs1[3] + v1[3] * cs1[2];
                    v4u w; w.x = cvt_pk_bf16(o0 * sc, o1 * sc); w.y = cvt_pk_bf16(o2 * sc, o3 * sc); w.z = cvt_pk_bf16(o4 * sc, o5 * sc); w.w = cvt_pk_bf16(o6 * sc, o7 * sc);
                    *(v4u*)(O + (size_t)row * NPROJ + col0 + bj * 128) = w;
                }
            }
    }
};

__device__ __forceinline__ void glds16(const void* gsrc, unsigned lds_dst) { unsigned keep;
    asm volatile("s_mov_b32 %0, m0\n\ts_mov_b32 m0, %2\n\ts_nop 0\n\tglobal_load_lds_dwordx4 %1, off\n\ts_mov_b32 m0, %0" : "=&s"(keep) : "v"(gsrc), "s"(lds_dst) : "memory"); }
#define WAIT_BAR(N) asm volatile("s_waitcnt vmcnt(" #N ") lgkmcnt(0)\n\ts_barrier" ::: "memory")
#define LBAR() asm volatile("s_waitcnt lgkmcnt(0)\n\ts_barrier" ::: "memory")
typedef LAS const unsigned char* lds_cptr;
__device__ __forceinline__ s16x4 vtr(lds_cptr p) { return __builtin_bit_cast(s16x4, __builtin_amdgcn_ds_read_tr16_b64_v4i16((LAS v4i16_t*)p)); }
#define MFMA32(a, b, c) __builtin_amdgcn_mfma_f32_32x32x16_bf16(a, b, c, 0, 0, 0)
__device__ __forceinline__ bf16x8 cat4(s16x4 lo, s16x4 hi) { return (bf16x8){lo[0], lo[1], lo[2], lo[3], hi[0], hi[1], hi[2], hi[3]}; }

__device__ __forceinline__ void qkt(f32x16& p0, f32x16& p1, lds_cptr Kimg, const bf16x8* qr, int r32, int hi, const f32x16 cin) {
    lds_cptr kb = Kimg + r32 * 128; const int sw = (r32 >> 1) & 7;
    p0 = cin; p1 = cin;
#pragma unroll
    for (int d0 = 0; d0 < 4; ++d0) {
        const int co = ((2 * d0 + hi) ^ sw) * 16;
        const bf16x8 b0 = *(const LAS bf16x8*)(kb + co);
        const bf16x8 b1 = *(const LAS bf16x8*)(kb + 4096 + co);
        p0 = MFMA32(b0, qr[d0], p0); p1 = MFMA32(b1, qr[d0], p1);
    }
}
__device__ __forceinline__ float rowmax32(const f32x16& p0, const f32x16& p1) {
    float a = fmaxf(p0[0], p1[0]);
#pragma unroll
    for (int r = 1; r < 16; ++r) a = fmaxf(a, fmaxf(p0[r], p1[r]));
    auto rr = __builtin_amdgcn_permlane32_swap(__float_as_uint(a), __float_as_uint(a), false, false);
    return fmaxf(__uint_as_float(rr[0]), __uint_as_float(rr[1]));
}

template <int MODE>
__device__ __forceinline__ void attn_unit(LAS unsigned char* lds, bf16* PROJ, int b, int h, int j, float lam, const float* subln_g, int tid, bf16* obase, int opitch, int dir, float& nm1, float& nm2, float& sgn) {
    const int lane = tid & 63, wid = __builtin_amdgcn_readfirstlane(tid >> 6), half = wid >> 2, wq = wid & 3, r32 = lane & 31, hi = lane >> 5;
    const size_t rowbase = (size_t)b * SEQ; const int q0 = 128 * j;
    const bf16* Qw = PROJ + (rowbase + q0 + 32 * wq) * NPROJ + C_DQ + 128 * h;
    const bf16* Kh = PROJ + rowbase * NPROJ + C_DK + 128 * h;
    const bf16* Vh = PROJ + rowbase * NPROJ + C_DV + 128 * h;
    const int nsteps = j + 1, cw = 2 * j + (wq >> 1);
#define TI(s_) ((dir ? 2 * (nsteps - 1 - (s_)) : 2 * (s_)) + half)
    bf16x8 q1[4], q2[4];
#pragma unroll
    for (int d0 = 0; d0 < 4; ++d0) { q1[d0] = *(const bf16x8*)(Qw + (size_t)r32 * NPROJ + d0 * 16 + hi * 8); q2[d0] = *(const bf16x8*)(Qw + (size_t)r32 * NPROJ + 64 + d0 * 16 + hi * 8); }
    const unsigned lds0 = (unsigned)(uintptr_t)lds;
    const unsigned hb = lds0 + (unsigned)half * 65536u;
    const bf16* ksrc = Kh + (size_t)(16 * wq + (lane >> 3)) * NPROJ + (((lane & 7) ^ (lane >> 4)) * 8);
    const bf16* ksrc2 = Kh + (size_t)(16 * wq + 8 + (lane >> 3)) * NPROJ + (((lane & 7) ^ (4 + (lane >> 4))) * 8);
    const bf16* vsrc = Vh + (size_t)(lane >> 2) * NPROJ + 32 * wq + (lane & 3) * 8;
#define DMA_K(t, buf) do { const bf16* s_ = ksrc + (size_t)(t) * 64 * NPROJ; const unsigned d_ = hb + (unsigned)(buf) * 32768u + (unsigned)(2 * wq) * 1024u; \
        glds16(s_, (unsigned)__builtin_amdgcn_readfirstlane(d_)); glds16(s_ + 64, (unsigned)__builtin_amdgcn_readfirstlane(d_ + 8192u)); \
        const bf16* s2_ = ksrc2 + (size_t)(t) * 64 * NPROJ; \
        glds16(s2_, (unsigned)__builtin_amdgcn_readfirstlane(d_ + 1024u)); glds16(s2_ + 64, (unsigned)__builtin_amdgcn_readfirstlane(d_ + 8192u + 1024u)); } while (0)
#define DMA_V(t, buf) do { const bf16* s_ = vsrc + (size_t)(t) * 64 * NPROJ; const unsigned d_ = hb + (unsigned)(buf) * 32768u + 16384u + (unsigned)(wq * 4) * 1024u; \
        _Pragma("unroll") for (int rg_ = 0; rg_ < 4; ++rg_) glds16(s_ + (size_t)rg_ * 16 * NPROJ, (unsigned)__builtin_amdgcn_readfirstlane(d_ + (unsigned)rg_ * 1024u)); } while (0)
    lds_cptr hbp = (lds_cptr)lds + half * 65536;
#define ACT(s_) (TI(s_) <= cw)
#define UPD(P0, P1, M, L) do { const float rm_ = rowmax32(P0, P1), mn_ = fmaxf(M, rm_); float sacc_ = 0.f; \
        _Pragma("unroll") for (int r = 0; r < 16; ++r) sacc_ += ex2(P0[r] - mn_) + ex2(P1[r] - mn_); \
        L = L * ex2(M - mn_) + sacc_; M = mn_; } while (0)
    f32x16 sa0 = f32x16{}, sa1 = f32x16{}, sb0 = f32x16{}, sb1 = f32x16{};
    if constexpr (MODE == 1) {
    float m1 = -INFINITY, l1 = 0.f, m2 = -INFINITY, l2 = 0.f;
    DMA_K(TI(0), 0);
    for (int s = 0; s < nsteps; ++s) {
        WAIT_BAR(0);
        if (s + 1 < nsteps) DMA_K(TI(s + 1), (s + 1) & 1);
        if (half == 1 && s > 0 && ACT(s - 1)) { UPD(sa0, sa1, m1, l1); UPD(sb0, sb1, m2, l2); }
        if (ACT(s)) { lds_cptr kb = hbp + (s & 1) * 32768; qkt(sa0, sa1, kb, q1, r32, hi, f32x16{}); qkt(sb0, sb1, kb + 8192, q2, r32, hi, f32x16{}); }
        if (half == 0 && ACT(s)) { UPD(sa0, sa1, m1, l1); UPD(sb0, sb1, m2, l2); }
    }
    if (half == 1 && ACT(nsteps - 1)) { UPD(sa0, sa1, m1, l1); UPD(sb0, sb1, m2, l2); }
    { auto rr = __builtin_amdgcn_permlane32_swap(__float_as_uint(l1), __float_as_uint(l1), false, false); l1 = __uint_as_float(rr[0]) + __uint_as_float(rr[1]); }
    { auto rr = __builtin_amdgcn_permlane32_swap(__float_as_uint(l2), __float_as_uint(l2), false, false); l2 = __uint_as_float(rr[0]) + __uint_as_float(rr[1]); }
    LAS float* st = (LAS float*)(lds + 131072);
    if (hi == 0) { LAS float* p = st + ((half * 4 + wq) * 4) * 32 + r32; p[0] = m1; p[32] = l1; p[64] = m2; p[96] = l2; }
    LBAR();
    { const LAS float* pa = st + ((0 * 4 + wq) * 4) * 32 + r32; const LAS float* pb = st + ((1 * 4 + wq) * 4) * 32 + r32;
      const float ma = pa[0], la = pa[32], mb = pb[0], lb = pb[32]; const float mf1 = fmaxf(ma, mb); const float lf1 = la * ex2(ma - mf1) + lb * ex2(mb - mf1);
      const float ma2 = pa[64], la2 = pa[96], mb2 = pb[64], lb2 = pb[96]; const float mf2 = fmaxf(ma2, mb2); const float lf2 = la2 * ex2(ma2 - mf2) + lb2 * ex2(mb2 - mf2);
      nm1 = -(mf1 + __builtin_amdgcn_logf(lf1)); nm2 = -(mf2 + __builtin_amdgcn_logf(lf2) - __builtin_amdgcn_logf(fabsf(lam))); sgn = lam > 0.f ? -1.f : 1.f; }
    LBAR();
    } else {
    f32x16 o[4];
#pragma unroll
    for (int d = 0; d < 4; ++d) o[d] = f32x16{};
    const int vro = ((lane >> 4) & 1) * 32 + (lane & 3) * 8 + (4 * hi + ((lane & 15) >> 2)) * 64;
    v4u pw[4];
#define EXPPACK() do { \
        _Pragma("unroll") for (int r = 0; r < 16; ++r) { sa0[r] = ex2(sa0[r] + nm1) + sgn * ex2(sb0[r] + nm2); sa1[r] = ex2(sa1[r] + nm1) + sgn * ex2(sb1[r] + nm2); } \
        pw[0] = (v4u){cvt_pk_bf16(sa0[0], sa0[1]), cvt_pk_bf16(sa0[2], sa0[3]), cvt_pk_bf16(sa0[4], sa0[5]), cvt_pk_bf16(sa0[6], sa0[7])}; \
        pw[1] = (v4u){cvt_pk_bf16(sa0[8], sa0[9]), cvt_pk_bf16(sa0[10], sa0[11]), cvt_pk_bf16(sa0[12], sa0[13]), cvt_pk_bf16(sa0[14], sa0[15])}; \
        pw[2] = (v4u){cvt_pk_bf16(sa1[0], sa1[1]), cvt_pk_bf16(sa1[2], sa1[3]), cvt_pk_bf16(sa1[4], sa1[5]), cvt_pk_bf16(sa1[6], sa1[7])}; \
        pw[3] = (v4u){cvt_pk_bf16(sa1[8], sa1[9]), cvt_pk_bf16(sa1[10], sa1[11]), cvt_pk_bf16(sa1[12], sa1[13]), cvt_pk_bf16(sa1[14], sa1[15])}; } while (0)
#define PVSTEP(slot_) do { \
        lds_cptr vp = hbp + (slot_) * 32768 + 16384 + vro; \
        _Pragma("unroll") for (int d = 0; d < 4; ++d) { \
            _Pragma("unroll") for (int ks = 0; ks < 4; ++ks) { \
                const s16x4 lo = vtr(vp + d * 4096 + ks * 1024), hh = vtr(vp + d * 4096 + ks * 1024 + 512); \
                o[d] = MFMA32(__builtin_bit_cast(bf16x8, pw[ks]), cat4(lo, hh), o[d]); } \
            __builtin_amdgcn_sched_barrier(0); } } while (0)
    DMA_K(TI(0), 0); if (half == 0) DMA_V(TI(0), 0);
    for (int s = 0; s < nsteps; ++s) {
        WAIT_BAR(0);
        if (s + 1 < nsteps) DMA_K(TI(s + 1), (s + 1) & 1);
        if (half == 0) { if (s + 1 < nsteps) DMA_V(TI(s + 1), (s + 1) & 1); } else { DMA_V(TI(s), s & 1); }
        if (half == 1 && s > 0 && ACT(s - 1)) PVSTEP((s - 1) & 1);
        if (ACT(s)) { lds_cptr kb = hbp + (s & 1) * 32768; qkt(sa0, sa1, kb, q1, r32, hi, f32x16{}); qkt(sb0, sb1, kb + 8192, q2, r32, hi, f32x16{}); EXPPACK(); }
        if (half == 0 && ACT(s)) PVSTEP(s & 1);
    }
    WAIT_BAR(0);
    if (half == 1 && ACT(nsteps - 1)) PVSTEP((nsteps - 1) & 1);
    LBAR();
#undef EXPPACK
#undef ACT
#undef UPD
#undef PVSTEP
    LAS float* ox = (LAS float*)lds;
    if (half == 1) {
#pragma unroll
        for (int d = 0; d < 4; ++d)
#pragma unroll
            for (int r = 0; r < 16; ++r) ox[((wq * 4 + d) * 16 + r) * 64 + lane] = o[d][r];
    }
    LBAR();
    LAS float* ot = (LAS float*)(lds + 65536);
    if (half == 0) {
#pragma unroll
        for (int d = 0; d < 4; ++d)
#pragma unroll
            for (int r = 0; r < 16; ++r) { const float v = o[d][r] + ox[((wq * 4 + d) * 16 + r) * 64 + lane]; ot[(wq * 32 + crow(r, hi)) * 132 + 32 * d + r32] = v; }
        LDS_WAIT();
        const int q = lane >> 1, c0 = 64 * (lane & 1);
        const LAS f32x4* src = (const LAS f32x4*)(ot + (wq * 32 + q) * 132 + c0);
        f32x4 v[16]; float ss = 0.f;
#pragma unroll
        for (int i = 0; i < 16; ++i) { v[i] = src[i]; ss += (v[i].x * v[i].x + v[i].y * v[i].y) + (v[i].z * v[i].z + v[i].w * v[i].w); }
        ss += __shfl_xor(ss, 1);
        const float rs = (1.f - LAM_INIT) / sqrtf(ss * (1.f / 128.f) + LN_EPS);
        bf16* dst = obase + (rowbase + q0 + 32 * wq + q) * opitch + 128 * h + c0;
#pragma unroll
        for (int i = 0; i < 8; ++i) {
            const f32x4 ga = *(const f32x4*)(subln_g + c0 + 8 * i), gb = *(const f32x4*)(subln_g + c0 + 8 * i + 4);
            const f32x4 x0 = v[2 * i] * rs * ga, x1 = v[2 * i + 1] * rs * gb;
            v4u w; w.x = cvt_pk_bf16(x0.x, x0.y); w.y = cvt_pk_bf16(x0.z, x0.w); w.z = cvt_pk_bf16(x1.x, x1.y); w.w = cvt_pk_bf16(x1.z, x1.w);
            *(v4u*)(dst + 8 * i) = w;
        }
    }
    LBAR();
    }
#undef TI
#undef DMA_K
#undef DMA_V
}

__device__ __forceinline__ int tr_nat_off(int lane) { return ((lane >> 4) & 1) * 32 + (lane & 3) * 8 + (8 * (lane >> 5) + ((lane & 15) >> 2)) * 64; }
constexpr size_t BC_OFF_FLOATS = 8u * 1024u * 1024u;

__device__ __forceinline__ void gla_a_wave(const Args& a, LAS unsigned char* wl, int unit, int lane) {
    const int bh = unit >> 5, n = unit & 31, b = bh >> 2, h = bh & 3, hi = lane >> 5;
    const size_t row0 = (size_t)b * SEQ + n * 64;
    const bf16* PROJ = (const bf16*)(a.ws + WS_A);
    const unsigned wl0 = (unsigned)(uintptr_t)wl;
#pragma unroll
    for (int p = 0; p < 16; ++p) { const int dblk = p >> 2, rg = p & 3;
        glds16(PROJ + (row0 + 16 * rg + (lane >> 2)) * NPROJ + C_GV + 128 * h + 32 * dblk + (lane & 3) * 8, (unsigned)__builtin_amdgcn_readfirstlane(wl0 + p * 1024)); }
    float w2[16];
#pragma unroll
    for (int r = 0; r < 16; ++r) w2[r] = a.wg2[r * 256 + 64 * h + lane];
    const float b2 = a.bg2[64 * h + lane];
    const f32x4* gp = (const f32x4*)((const float*)(a.ws + WS_GLOW) + (row0 + lane) * 16);
    const f32x4 g0 = gp[0], g1 = gp[1], g2 = gp[2], g3 = gp[3];
    const float grow[16] = {g0.x, g0.y, g0.z, g0.w, g1.x, g1.y, g1.z, g1.w, g2.x, g2.y, g2.z, g2.w, g3.x, g3.y, g3.z, g3.w};
    const bf16* kp = PROJ + row0 * NPROJ + C_GK + 64 * h + lane;
    float* BC = a.out + BC_OFF_FLOATS + (size_t)unit * 4096 + lane;
    LAS bf16* kimg = (LAS bf16*)(wl + 16384) + (lane >> 5) * 2048 + (lane & 31);
    float run = 0.f;
#pragma unroll
    for (int tb = 0; tb < 4; ++tb) {
        float kv[16];
#pragma unroll
        for (int i = 0; i < 16; ++i) kv[i] = bf_lo((unsigned)kp[(size_t)(16 * tb + i) * NPROJ]);
#pragma unroll
        for (int i = 0; i < 16; ++i) { const int t = 16 * tb + i;
            float z = b2;
#pragma unroll
            for (int r = 0; r < 16; ++r) z += __builtin_bit_cast(float, __builtin_amdgcn_readlane(__builtin_bit_cast(int, grow[r]), t)) * w2[r];
            run += (fminf(z, 0.f) - __logf(1.f + __expf(-fabsf(z)))) * (1.f / 16.f);
            BC[t * 64] = run;
            kimg[tb * 512 + i * 32] = (bf16)(cvt_pk_bf16(kv[i] * __expf(-run), 0.f) & 0xffffu);
        }
    }
    ((float*)(a.ws + WS_DEC))[(size_t)unit * 64 + lane] = __expf(run);
    asm volatile("s_waitcnt vmcnt(0) lgkmcnt(0)" ::: "memory");
    const int tro = tr_nat_off(lane);
    bf16x8 af[2][4];
#pragma unroll
    for (int db = 0; db < 2; ++db)
#pragma unroll
        for (int sk = 0; sk < 4; ++sk) { lds_cptr p = (lds_cptr)wl + 16384 + db * 4096 + sk * 1024 + tro; af[db][sk] = cat4(vtr(p), vtr(p + 256)); }
    bf16* DS = (bf16*)(a.ws + WS_DS) + (size_t)unit * 8192;
#pragma unroll
    for (int eb = 0; eb < 4; ++eb) {
        f32x16 acc0 = f32x16{}, acc1 = f32x16{};
#pragma unroll
        for (int sk = 0; sk < 4; ++sk) { lds_cptr p = (lds_cptr)wl + eb * 4096 + sk * 1024 + tro; const bf16x8 bfr = cat4(vtr(p), vtr(p + 256));
            acc0 = MFMA32(af[0][sk], bfr, acc0); acc1 = MFMA32(af[1][sk], bfr, acc1); }
        const int e = 32 * eb + (lane & 31);
#pragma unroll
        for (int r = 0; r < 16; r += 2) { const unsigned p0 = cvt_pk_bf16(acc0[r], acc0[r + 1]), p1 = cvt_pk_bf16(acc1[r], acc1[r + 1]);
            DS[crow(r, hi) * 128 + e] = (bf16)(p0 & 0xffffu); DS[crow(r + 1, hi) * 128 + e] = (bf16)(p0 >> 16);
            DS[(32 + crow(r, hi)) * 128 + e] = (bf16)(p1 & 0xffffu); DS[(32 + crow(r + 1, hi)) * 128 + e] = (bf16)(p1 >> 16); }
    }
    asm volatile("s_waitcnt lgkmcnt(0)" ::: "memory");
}

__device__ __forceinline__ void gla_c_wave(const Args& a, LAS unsigned char* ul, int unit, int cb, bool valid, int lane, bool dry) {
    const int r32 = lane & 31, hi = lane >> 5;
    const int bh = unit >> 5, n = unit & 31, b = bh >> 2, h = bh & 3;
    const size_t row0 = (size_t)b * SEQ + n * 64;
    bf16* PROJ = (bf16*)(a.ws + WS_A);
    const int c = 32 * cb + r32;
    bf16x8 qf[4], kf[2][4];
#pragma unroll
    for (int d0 = 0; d0 < 4; ++d0) { qf[d0] = bf16x8{}; kf[0][d0] = bf16x8{}; kf[1][d0] = bf16x8{}; }
    if (valid) {
        const unsigned ul0 = (unsigned)(uintptr_t)ul;
        const bf16* SP = (const bf16*)(a.ws + WS_SP) + (size_t)unit * 8192;
#pragma unroll
        for (int p = 0; p < 8; ++p) { const int pp = 8 * cb + p, dblk = pp >> 2, rg = pp & 3;
            glds16(PROJ + (row0 + 16 * rg + (lane >> 2)) * NPROJ + C_GV + 128 * h + 32 * dblk + (lane & 3) * 8, (unsigned)__builtin_amdgcn_readfirstlane(ul0 + pp * 1024));
            glds16(SP + (16 * rg + (lane >> 2)) * 128 + 32 * dblk + (lane & 3) * 8, (unsigned)__builtin_amdgcn_readfirstlane(ul0 + 16384 + pp * 1024)); }
        const float* BC = a.out + BC_OFF_FLOATS + (size_t)unit * 4096;
#pragma unroll
        for (int d0 = 0; d0 < 4; ++d0) {
            { const v4u qq = *(const v4u*)(PROJ + (row0 + c) * NPROJ + C_GQ + 64 * h + 16 * d0 + 8 * hi);
              const f32x4 c0 = *(const f32x4*)(BC + c * 64 + 16 * d0 + 8 * hi), c1 = *(const f32x4*)(BC + c * 64 + 16 * d0 + 8 * hi + 4); v4u w;
              w.x = cvt_pk_bf16(bf_lo(qq.x) * 0.125f * __expf(c0.x), bf_hi(qq.x) * 0.125f * __expf(c0.y));
              w.y = cvt_pk_bf16(bf_lo(qq.y) * 0.125f * __expf(c0.z), bf_hi(qq.y) * 0.125f * __expf(c0.w));
              w.z = cvt_pk_bf16(bf_lo(qq.z) * 0.125f * __expf(c1.x), bf_hi(qq.z) * 0.125f * __expf(c1.y));
              w.w = cvt_pk_bf16(bf_lo(qq.w) * 0.125f * __expf(c1.z), bf_hi(qq.w) * 0.125f * __expf(c1.w));
              qf[d0] = __builtin_bit_cast(bf16x8, w); }
#pragma unroll
            for (int jb = 0; jb < 2; ++jb) if (jb <= cb) { const int jr = 32 * jb + r32;
                const v4u kk = *(const v4u*)(PROJ + (row0 + jr) * NPROJ + C_GK + 64 * h + 16 * d0 + 8 * hi);
                const f32x4 c0 = *(const f32x4*)(BC + jr * 64 + 16 * d0 + 8 * hi), c1 = *(const f32x4*)(BC + jr * 64 + 16 * d0 + 8 * hi + 4); v4u w;
                w.x = cvt_pk_bf16(bf_lo(kk.x) * __expf(-c0.x), bf_hi(kk.x) * __expf(-c0.y));
                w.y = cvt_pk_bf16(bf_lo(kk.y) * __expf(-c0.z), bf_hi(kk.y) * __expf(-c0.w));
                w.z = cvt_pk_bf16(bf_lo(kk.z) * __expf(-c1.x), bf_hi(kk.z) * __expf(-c1.y));
                w.w = cvt_pk_bf16(bf_lo(kk.w) * __expf(-c1.z), bf_hi(kk.w) * __expf(-c1.w));
                kf[jb][d0] = __builtin_bit_cast(bf16x8, w); }
        }
    }
    WAIT_BAR(0);
    f32x16 o[4];
#pragma unroll
    for (int eb = 0; eb < 4; ++eb) o[eb] = f32x16{};
    if (valid) {
        const int vro = ((lane >> 4) & 1) * 32 + (lane & 3) * 8 + (4 * hi + ((lane & 15) >> 2)) * 64;
#pragma unroll
        for (int jb = 0; jb < 2; ++jb) if (jb <= cb) {
            f32x16 X = f32x16{};
#pragma unroll
            for (int d0 = 0; d0 < 4; ++d0) X = MFMA32(kf[jb][d0], qf[d0], X);
            if (jb == cb) {
#pragma unroll
                for (int r = 0; r < 16; ++r) if (crow(r, hi) > r32) X[r] = 0.f;
            }
            const v4u pw0 = (v4u){cvt_pk_bf16(X[0], X[1]), cvt_pk_bf16(X[2], X[3]), cvt_pk_bf16(X[4], X[5]), cvt_pk_bf16(X[6], X[7])};
            const v4u pw1 = (v4u){cvt_pk_bf16(X[8], X[9]), cvt_pk_bf16(X[10], X[11]), cvt_pk_bf16(X[12], X[13]), cvt_pk_bf16(X[14], X[15])};
#pragma unroll
            for (int eb = 0; eb < 4; ++eb) { lds_cptr vp = (lds_cptr)ul + eb * 4096 + vro;
                o[eb] = MFMA32(__builtin_bit_cast(bf16x8, pw0), cat4(vtr(vp + (2 * jb) * 1024), vtr(vp + (2 * jb) * 1024 + 512)), o[eb]);
                o[eb] = MFMA32(__builtin_bit_cast(bf16x8, pw1), cat4(vtr(vp + (2 * jb + 1) * 1024), vtr(vp + (2 * jb + 1) * 1024 + 512)), o[eb]); }
        }
        const int tro = tr_nat_off(lane);
#pragma unroll
        for (int eb = 0; eb < 4; ++eb)
#pragma unroll
            for (int d0 = 0; d0 < 4; ++d0) { lds_cptr sp = (lds_cptr)ul + 16384 + eb * 4096 + d0 * 1024 + tro; o[eb] = MFMA32(qf[d0], cat4(vtr(sp), vtr(sp + 256)), o[eb]); }
    }
    LBAR();
    if (valid) {
        LAS float* os = (LAS float*)(ul + cb * 16384);
#pragma unroll
        for (int eb = 0; eb < 4; ++eb)
#pragma unroll
            for (int r = 0; r < 16; ++r) { const int rr = crow(r, hi), e = 32 * eb + r32; os[rr * 128 + (((e >> 2) + rr) & 31) * 4 + (e & 3)] = o[eb][r]; }
        asm volatile("s_waitcnt lgkmcnt(0)" ::: "memory");
        const int rr = lane >> 1, hf = lane & 1;
        f32x4 v[16]; float ss = 0.f;
#pragma unroll
        for (int i = 0; i < 16; ++i) { v[i] = *(const LAS f32x4*)(os + rr * 128 + ((16 * hf + i + rr) & 31) * 4); ss += (v[i].x * v[i].x + v[i].y * v[i].y) + (v[i].z * v[i].z + v[i].w * v[i].w); }
        ss += __shfl_xor(ss, 1);
        const float rs = 1.f / sqrtf(ss * (1.f / 128.f) + LN_EPS);
        bf16* gp = PROJ + (row0 + 32 * cb + rr) * NPROJ + C_GO + 128 * h + 64 * hf;
        bf16* op = dry ? (bf16*)a.out + (row0 + 32 * cb + rr) * 512 + 128 * h + 64 * hf : gp;
#pragma unroll
        for (int i = 0; i < 8; ++i) {
            const v4u gg = *(const v4u*)(gp + 8 * i);
            const f32x4 gn0 = *(const f32x4*)(a.gla_norm_g + 64 * hf + 8 * i), gn1 = *(const f32x4*)(a.gla_norm_g + 64 * hf + 8 * i + 4);
            const float g0 = bf_lo(gg.x), g1 = bf_hi(gg.x), g2 = bf_lo(gg.y), g3 = bf_hi(gg.y), g4 = bf_lo(gg.z), g5 = bf_hi(gg.z), g6 = bf_lo(gg.w), g7 = bf_hi(gg.w);
            const f32x4 x0 = v[2 * i] * rs * gn0, x1 = v[2 * i + 1] * rs * gn1;
            v4u w;
            w.x = cvt_pk_bf16(x0.x * g0 / (1.f + __expf(-g0)), x0.y * g1 / (1.f + __expf(-g1)));
            w.y = cvt_pk_bf16(x0.z * g2 / (1.f + __expf(-g2)), x0.w * g3 / (1.f + __expf(-g3)));
            w.z = cvt_pk_bf16(x1.x * g4 / (1.f + __expf(-g4)), x1.y * g5 / (1.f + __expf(-g5)));
            w.w = cvt_pk_bf16(x1.z * g6 / (1.f + __expf(-g6)), x1.w * g7 / (1.f + __expf(-g7)));
            *(v4u*)(op + 8 * i) = w;
        }
    }
    LBAR();
}

struct EpiPre1 {
    static constexpr bool PERM = false;
    float* out; const float* x; const float* stats; const float* g; const float* bta;
    __device__ __forceinline__ void operator()(const f32x4 (&acc)[2][2][4][2], const pg8::Unit& u, int wr, int wc, int fr, int fq) const {
        const int row0 = u.pm * 256 + wr * 64 + fr, col0 = u.pn * 256 + wc * 32 + 4 * fq;
        f32x4 gv[2][2], bv[2][2];
#pragma unroll
        for (int bj = 0; bj < 2; ++bj)
#pragma unroll
            for (int n = 0; n < 2; ++n) { gv[bj][n] = *(const f32x4*)(g + col0 + bj * 128 + n * 16); bv[bj][n] = *(const f32x4*)(bta + col0 + bj * 128 + n * 16); }
#pragma unroll
        for (int ai = 0; ai < 2; ++ai)
#pragma unroll
            for (int m = 0; m < 4; ++m) {
                const int row = row0 + ai * 128 + m * 16; const f32x2 st = *(const f32x2*)(stats + 2 * (size_t)row); const size_t off = (size_t)row * D + col0;
#pragma unroll
                for (int bj = 0; bj < 2; ++bj)
#pragma unroll
                    for (int n = 0; n < 2; ++n) { const f32x4 xv = *(const f32x4*)(x + off + bj * 128 + n * 16);
                        const f32x4 xn = (xv - st.x) * st.y * gv[bj][n] + bv[bj][n];
                        *(f32x4*)(out + off + bj * 128 + n * 16) = acc[ai][bj][m][n] + ALPHA * xn; }
            }
    }
};

struct MoeOrder {
    const int* cntl; const int* tst;
    const char* A; const char* B; const int* ltok; int lda, K, G, c; bool gather; size_t bstride_e;
    __device__ __forceinline__ bool next(int i, pg8::Unit& u) const {
        const volatile LAS int* cn = (const volatile LAS int*)cntl; const volatile LAS int* ts = (const volatile LAS int*)tst;
        const int ntot = ts[32], nun = 4 * ntot; int L;
        if ((G & 7) == 0) { const int chunk = (nun + 7) >> 3, cpx = G >> 3, xcd = c & 7, loc = c >> 3; const int o = i * cpx + loc; if (o >= chunk) return false; L = xcd * chunk + o; }
        else L = i * G + c;
        if (L >= nun) return false;
        const int tt = L >> 2, pn = L & 3; int e = 0;
        for (int k = 1; k < 32; ++k) e += (ts[k] <= tt) ? 1 : 0;
        u.pm = tt; u.pn = pn; u.e = e; u.r0 = (tt - ts[e]) * 256; u.cnt = cn[e];
        u.B = B + (size_t)e * bstride_e + (size_t)pn * 256 * K * 2;
        const int tid = threadIdx.x; int R0, C0, R1, C1; pg8::stage_rc(tid * 16, R0, C0); pg8::stage_rc(tid * 16 + 8192, R1, C1);
        if (gather) {
            u.A = A;
            const int s00 = u.r0 + R0, s01 = u.r0 + R1, s10 = u.r0 + 128 + R0, s11 = u.r0 + 128 + R1;
            const int t00 = s00 < u.cnt ? (ltok[e * LCAP + s00] >> 1) : 0, t01 = s01 < u.cnt ? (ltok[e * LCAP + s01] >> 1) : 0;
            const int t10 = s10 < u.cnt ? (ltok[e * LCAP + s10] >> 1) : 0, t11 = s11 < u.cnt ? (ltok[e * LCAP + s11] >> 1) : 0;
            u.va00 = (unsigned)(t00 * lda + C0) * 2u; u.va01 = (unsigned)(t01 * lda + C1) * 2u; u.va10 = (unsigned)(t10 * lda + C0) * 2u; u.va11 = (unsigned)(t11 * lda + C1) * 2u;
        } else {
            u.A = A + (size_t)tt * 256 * lda * 2;
            u.va00 = (unsigned)(R0 * lda + C0) * 2u; u.va01 = (unsigned)(R1 * lda + C1) * 2u; u.va10 = (unsigned)((128 + R0) * lda + C0) * 2u; u.va11 = (unsigned)((128 + R1) * lda + C1) * 2u;
        }
        return true;
    }
};
struct EpiGU {
    static constexpr bool PERM = true;
    bf16* H;
    __device__ __forceinline__ void operator()(const f32x4 (&acc)[2][2][4][2], const pg8::Unit& u, int wr, int wc, int fr, int fq) const {
        const int row0 = u.pm * 256 + wr * 64 + fr, col0 = u.pn * 128 + wc * 32 + 8 * fq;
#pragma unroll
        for (int ai = 0; ai < 2; ++ai)
#pragma unroll
            for (int m = 0; m < 4; ++m) {
                float hv[8];
#pragma unroll
                for (int n = 0; n < 2; ++n)
#pragma unroll
                    for (int i = 0; i < 4; ++i) { const float g = acc[ai][0][m][n][i], up = acc[ai][1][m][n][i]; hv[4 * n + i] = g / (1.f + __expf(-g)) * up; }
                v4u w; w.x = cvt_pk_bf16(hv[0], hv[1]); w.y = cvt_pk_bf16(hv[2], hv[3]); w.z = cvt_pk_bf16(hv[4], hv[5]); w.w = cvt_pk_bf16(hv[6], hv[7]);
                *(v4u*)(H + (size_t)(row0 + ai * 128 + m * 16) * DE + col0) = w;
            }
    }
};
struct EpiDown {
    static constexpr bool PERM = true;
    bf16* Y; const int* ltok; const float* lw;
    __device__ __forceinline__ void operator()(const f32x4 (&acc)[2][2][4][2], const pg8::Unit& u, int wr, int wc, int fr, int fq) const {
        const int col0 = u.pn * 256 + wc * 32 + 8 * fq;
#pragma unroll
        for (int ai = 0; ai < 2; ++ai)
#pragma unroll
            for (int m = 0; m < 4; ++m) {
                const int slot = u.r0 + ai * 128 + wr * 64 + m * 16 + fr;
                if (slot < u.cnt) {
                    const int ent = ltok[u.e * LCAP + slot]; const float w = lw[u.e * LCAP + slot];
                    bf16* dst = Y + ((size_t)(ent >> 1) * 2 + (ent & 1)) * D + col0;
#pragma unroll
                    for (int bj = 0; bj < 2; ++bj) { const f32x4 v0 = acc[ai][bj][m][0] * w, v1 = acc[ai][bj][m][1] * w;
                        v4u o; o.x = cvt_pk_bf16(v0[0], v0[1]); o.y = cvt_pk_bf16(v0[2], v0[3]); o.z = cvt_pk_bf16(v1[0], v1[1]); o.w = cvt_pk_bf16(v1[2], v1[3]);
                        *(v4u*)(dst + bj * 128) = o; }
                }
            }
    }
};

constexpr int P6_TP = 2064;
constexpr int P6_HI = 0, P6_LO = 16 * P6_TP, P6_RED = 2 * 16 * P6_TP, P6_LG = P6_RED + 8 * 3 * 4 * 64 * 4, P6_SE = P6_LG + 16 * 48 * 4;
__device__ __forceinline__ void phase6(const Args& a, LAS unsigned char* lds, int G, int tid, int lane, int wave, bool dry) {
    unsigned char* ws = a.ws;
    const float* pre = a.out; bf16* HB = (bf16*)(ws + WS_HB);
    int* ltok = (int*)(ws + WS_LTOK); float* lw = (float*)(ws + WS_LW); unsigned* cntg = (unsigned*)(ws + WS_CTL) + CW_CNT;
    LAS int* s_e = (LAS int*)(lds + P6_SE);
    LAS float* s_w = (LAS float*)(lds + P6_SE + 512);
    LAS int* s_rank = (LAS int*)(lds + P6_SE + 1024);
    LAS unsigned* s_cnt = (LAS unsigned*)(lds + P6_SE + 1536);
    LAS unsigned* s_base = (LAS unsigned*)(lds + P6_SE + 1664);
    LAS float* s_lg = (LAS float*)(lds + P6_LG);
    LAS float* red = (LAS float*)(lds + P6_RED);
    const bf16* WRT = (const bf16*)(ws + WS_WRT);
    bf16x8 wh[3][4], wl[3][4];
#pragma unroll
    for (int ct = 0; ct < 3; ++ct)
#pragma unroll
        for (int sk = 0; sk < 4; ++sk) { const size_t off = (size_t)(16 * ct + (lane & 15)) * 1024 + 128 * wave + 32 * sk + 8 * (lane >> 4);
            wh[ct][sk] = *(const bf16x8*)(WRT + off); wl[ct][sk] = *(const bf16x8*)(WRT + 48 * 1024 + off); }
    for (int rb = blockIdx.x; rb < T / 64; rb += G) {
        if (tid < 32) s_cnt[tid] = 0u;
        for (int grp = 0; grp < 4; ++grp) {
#pragma unroll
            for (int q = 0; q < 2; ++q) {
                const int rl = 2 * wave + q; const size_t m = (size_t)rb * 64 + grp * 16 + rl;
                const GAS f32x4* xr = (const GAS f32x4*)(pre + m * D) + lane;
                f32x4 v[4]; float s = 0.f;
#pragma unroll
                for (int j = 0; j < 4; ++j) { v[j] = xr[64 * j]; s += (v[j].x + v[j].y) + (v[j].z + v[j].w); }
                const float mean = wave_sum(s) * (1.f / D); float s2 = 0.f;
#pragma unroll
                for (int j = 0; j < 4; ++j) { v[j] = v[j] - mean; s2 += (v[j].x * v[j].x + v[j].y * v[j].y) + (v[j].z * v[j].z + v[j].w * v[j].w); }
                const float rstd = 1.f / sqrtf(wave_sum(s2) * (1.f / D) + LN_EPS);
                GAS v2u* o8 = (GAS v2u*)(HB + m * D) + lane;
#pragma unroll
                for (int j = 0; j < 4; ++j) {
                    v[j] = v[j] * rstd * *(const f32x4*)(a.ln1_g + 4 * lane + 256 * j) + *(const f32x4*)(a.ln1_b + 4 * lane + 256 * j);
                    v2u hw; hw.x = cvt_pk_bf16(v[j].x, v[j].y); hw.y = cvt_pk_bf16(v[j].z, v[j].w); o8[64 * j] = hw;
                    v2u lw2; lw2.x = cvt_pk_bf16(v[j].x - bf_lo(hw.x), v[j].y - bf_hi(hw.x)); lw2.y = cvt_pk_bf16(v[j].z - bf_lo(hw.y), v[j].w - bf_hi(hw.y));
                    *(LAS v2u*)(lds + P6_HI + rl * P6_TP + (4 * lane + 256 * j) * 2) = hw;
                    *(LAS v2u*)(lds + P6_LO + rl * P6_TP + (4 * lane + 256 * j) * 2) = lw2;
                }
            }
            __syncthreads();
            {
                f32x4 acc[3];
#pragma unroll
                for (int ct = 0; ct < 3; ++ct) acc[ct] = (f32x4){0.f, 0.f, 0.f, 0.f};
#pragma unroll
                for (int sk = 0; sk < 4; ++sk) {
                    const int boff = (lane & 15) * P6_TP + (128 * wave + 32 * sk + 8 * (lane >> 4)) * 2;
                    const bf16x8 ah = *(const LAS bf16x8*)(lds + P6_HI + boff), al = *(const LAS bf16x8*)(lds + P6_LO + boff);
#pragma unroll
                    for (int ct = 0; ct < 3; ++ct) {
                        acc[ct] = __builtin_amdgcn_mfma_f32_16x16x32_bf16(ah, wh[ct][sk], acc[ct], 0, 0, 0);
                        acc[ct] = __builtin_amdgcn_mfma_f32_16x16x32_bf16(al, wh[ct][sk], acc[ct], 0, 0, 0);
                        acc[ct] = __builtin_amdgcn_mfma_f32_16x16x32_bf16(ah, wl[ct][sk], acc[ct], 0, 0, 0);
                    }
                }
#pragma unroll
                for (int ct = 0; ct < 3; ++ct)
#pragma unroll
                    for (int r = 0; r < 4; ++r) red[((wave * 3 + ct) * 4 + r) * 64 + lane] = acc[ct][r];
            }
            __syncthreads();
            for (int o = tid; o < 16 * 48; o += 512) {
                const int row = o / 48, col = o % 48, ct = col >> 4, ls = (col & 15) + 16 * (row >> 2), r = row & 3; float sum = 0.f;
#pragma unroll
                for (int w = 0; w < 8; ++w) sum += red[((w * 3 + ct) * 4 + r) * 64 + ls];
                s_lg[row * 48 + col] = sum;
            }
            __syncthreads();
            if (tid < 16) {
                const LAS float* lgp = s_lg + tid * 48;
                float gq[4];
#pragma unroll
                for (int k = 0; k < 4; ++k) gq[k] = lgp[k] + a.b_rg[k];
                int gt = 0; float gm = gq[0];
#pragma unroll
                for (int k = 1; k < 4; ++k) if (gq[k] > gm) { gm = gq[k]; gt = k; }
                float den = 0.f;
#pragma unroll
                for (int k = 0; k < 4; ++k) den += __expf(gq[k] - gm);
                const float pg = 1.f / den;
                float ev[8];
#pragma unroll
                for (int k = 0; k < 8; ++k) ev[k] = lgp[4 + 8 * gt + k] + a.b_re[8 * gt + k];
                int i0 = 0; float v0 = ev[0];
#pragma unroll
                for (int k = 1; k < 8; ++k) if (ev[k] > v0) { v0 = ev[k]; i0 = k; }
                int i1 = 0; float v1 = -INFINITY;
#pragma unroll
                for (int k = 0; k < 8; ++k) if (k != i0 && ev[k] > v1) { v1 = ev[k]; i1 = k; }
                const float t = __expf(v1 - v0), w0 = pg / (1.f + t), w1 = pg * t / (1.f + t);
                const int aidx = (grp * 16 + tid) * 2; s_e[aidx] = 8 * gt + i0; s_w[aidx] = w0; s_e[aidx + 1] = 8 * gt + i1; s_w[aidx + 1] = w1;
            }
        }
        __syncthreads();
        if (dry) continue;
        if (tid < 128) s_rank[tid] = (int)atomicAdd((unsigned*)&s_cnt[s_e[tid]], 1u);
        __syncthreads();
        if (tid < 32) s_base[tid] = s_cnt[tid] ? __hip_atomic_fetch_add(cntg + tid, s_cnt[tid], RLX_AGENT) : 0u;
        __syncthreads();
        if (tid < 128) { const int e = s_e[tid]; const unsigned slot = s_base[e] + (unsigned)s_rank[tid]; const int tok = rb * 64 + (tid >> 1);
            ltok[e * LCAP + slot] = (tok << 1) | (tid & 1); lw[e * LCAP + slot] = s_w[tid]; }
        __syncthreads();
    }
}

constexpr int NPH = 10;
__global__ void __launch_bounds__(512, 2) fwd_kernel(Args a) {
    extern __shared__ __attribute__((aligned(16))) unsigned char lds_raw[];
    LAS unsigned char* lds = (LAS unsigned char*)lds_raw;
    const int tid = threadIdx.x, lane = tid & 63, wave = __builtin_amdgcn_readfirstlane(tid >> 6);
    const int G = gridDim.x; const int bx = blockIdx.x; const int vcu = (G % 8 == 0) ? (bx % 8) * (G / 8) + bx / 8 : bx;
    unsigned char* ws = a.ws;
    unsigned* ctl = (unsigned*)(ws + WS_CTL);
    volatile LAS unsigned* MISC = (volatile LAS unsigned*)(lds + LDSCTL_OFF);
    for (int u = tid; u < 256; u += 512) ((LAS unsigned*)(lds + LDSCTL_OFF))[u] = 0u;
    __syncthreads();
    XcdBarrier bar; bar.bar = ctl + CW_BAR; bar.x = 0; bar.st = nullptr;
    if (!MK_SPLIT) bar = xcd_barrier_post(ctl + CW_BAR, MISC + 8);
    const int lo = a.ph_lo, hi_ph = a.ph_hi;
#ifndef PH_MASK
#define PH_MASK 0x3ff
#endif
#define IN(k) (((PH_MASK >> (k)) & 1) && lo <= (k) && (k) < hi_ph)
#ifndef REP_MASK
#define REP_MASK 0
#endif
#define REPS(k) _Pragma("unroll") for (int rep_ = 0; rep_ <= ((REP_MASK >> (k)) & 1); ++rep_)
#define SEAM(k) do { if (IN(k) && IN((k) + 1)) xcd_barrier(bar); } while (0)
    bf16* PROJ = (bf16*)(ws + WS_A);

    if (IN(0)) REPS(0) { phase0<1 + ((REP_MASK >> 10) & 1), 1 + ((REP_MASK >> 11) & 1), 1 + ((REP_MASK >> 12) & 1)>(a, lds, vcu, G, tid, lane, wave); __syncthreads(); }
    SEAM(0);
    if (IN(1)) REPS(1) {
        pg8::DenseOrder S; S.init(ws + WS_B, 1024, ws + WS_WIN, 1024, T, NPROJ, G, bx);
        EpiProj E{PROJ, (const float*)(ws + WS_ROPE)};
        pg8::gemm_phase<EpiProj, pg8::DenseOrder, true>(lds, 1024, S, E);
    }
    SEAM(1);
    if (IN(2)) {
        REPS(13) { if (wave < 4) for (int u = wave * G + vcu; u < 1024; u += 4 * G) gla_a_wave(a, lds + wave * 24576, u, lane); __syncthreads(); }
        float lam;
        { const float p1 = wave_sum(a.lam_q1[lane] * a.lam_k1[lane]), p2 = wave_sum(a.lam_q2[lane] * a.lam_k2[lane]); lam = expf(p1) - expf(p2) + LAM_INIT; }
        for (int pass = ((REP_MASK >> 2) & 1) ? 0 : 1; pass < 2; ++pass) {
            bf16* obase = pass ? PROJ + C_DQ : (bf16*)a.out; const int opitch = pass ? NPROJ : 512;
            for (int p = vcu; p < 256; p += G) {
                const int bh = p >> 3, jl = p & 7; float na1, na2, nb1, nb2, sg;
                attn_unit<1>(lds, PROJ, bh >> 2, bh & 3, 15 - jl, lam, a.subln_g, tid, obase, opitch, 0, na1, na2, sg);
                attn_unit<1>(lds, PROJ, bh >> 2, bh & 3, jl, lam, a.subln_g, tid, obase, opitch, 1, nb1, nb2, sg);
                attn_unit<2>(lds, PROJ, bh >> 2, bh & 3, 15 - jl, lam, a.subln_g, tid, obase, opitch, 0, na1, na2, sg);
                attn_unit<2>(lds, PROJ, bh >> 2, bh & 3, jl, lam, a.subln_g, tid, obase, opitch, 1, nb1, nb2, sg);
            }
        }
    }
    SEAM(2);
    if (IN(3)) REPS(3) {
        const bf16* DS = (const bf16*)(ws + WS_DS); bf16* SP = (bf16*)(ws + WS_SP); const float* DEC = (const float*)(ws + WS_DEC);
        for (int it = bx * 512 + tid; it < 32 * 64 * 64; it += G * 512) {
            const int bh = it >> 12, d = (it >> 6) & 63, ep = it & 63;
            float s0 = 0.f, s1 = 0.f;
#pragma unroll 4
            for (int n = 0; n < 32; ++n) {
                const size_t unit = (size_t)bh * 32 + n; const size_t idx = (unit * 64 + d) * 128 + 2 * ep;
                const unsigned dv = *(const unsigned*)(DS + idx); const float dc = DEC[unit * 64 + d];
                *(unsigned*)(SP + idx) = cvt_pk_bf16(s0, s1);
                s0 = dc * (s0 + bf_lo(dv)); s1 = dc * (s1 + bf_hi(dv));
            }
        }
    }
    SEAM(3);
    if (IN(4)) {
        for (int pass = ((REP_MASK >> 4) & 1) ? 0 : 1; pass < 2; ++pass)
            for (int u0 = vcu; u0 < 1024; u0 += 4 * G) { const int u = (wave >> 1) * G + u0;
                gla_c_wave(a, lds + (wave >> 1) * 32768, u < 1024 ? u : 0, wave & 1, u < 1024, lane, pass == 0); }
    }
    SEAM(4);
    if (IN(5)) REPS(5) {
        pg8::DenseOrder S; S.init(ws + WS_A, NPROJ, ws + WS_WO, 1024, T, D, G, bx);
        EpiPre1 E{a.out, a.x, (const float*)(ws + WS_STATS), a.ln_in_g, a.ln_in_b};
        pg8::gemm_phase<EpiPre1, pg8::DenseOrder, true>(lds, 1024, S, E);
    }
    SEAM(5);
    if (IN(6)) { for (int pass = ((REP_MASK >> 6) & 1) ? 0 : 1; pass < 2; ++pass) { phase6(a, lds, G, tid, lane, wave, pass == 0); __syncthreads(); } }
    SEAM(6);
    if (IN(7) || IN(8)) {
        LAS int* cntl = (LAS int*)(lds + LDSCTL_OFF + 64); LAS int* tst = (LAS int*)(lds + LDSCTL_OFF + 192);
        if (tid == 0) { int acc = 0; for (int e = 0; e < 32; ++e) { const int c = (int)__hip_atomic_load(ctl + CW_CNT + e, RLX_AGENT); cntl[e] = c; tst[e] = acc; acc += (c + 255) >> 8; } tst[32] = acc; }
        __syncthreads();
        if (IN(7)) REPS(7) {
            MoeOrder S{(const int*)cntl, (const int*)tst, (const char*)(ws + WS_HB), (const char*)(ws + WS_WGU), (const int*)(ws + WS_LTOK), 1024, 1024, G, bx, true, (size_t)1024 * 1024 * 2};
            EpiGU E{(bf16*)(ws + WS_B)};
            pg8::gemm_phase<EpiGU, MoeOrder, true>(lds, 1024, S, E);
        }
        SEAM(7);
        if (IN(8)) REPS(8) {
            MoeOrder S{(const int*)cntl, (const int*)tst, (const char*)(ws + WS_B), (const char*)(ws + WS_WD), (const int*)(ws + WS_LTOK), 512, 512, G, bx, false, (size_t)1024 * 512 * 2};
            EpiDown E{(bf16*)(ws + WS_Y), (const int*)(ws + WS_LTOK), (const float*)(ws + WS_LW)};
            pg8::gemm_phase<EpiDown, MoeOrder, true>(lds, 512, S, E);
        }
    }
    SEAM(8);
    if (IN(9)) REPS(9) {
        const bf16* HB = (const bf16*)(ws + WS_HB); const bf16* Y = (const bf16*)(ws + WS_Y);
        const int gw = vcu * 8 + wave, NGW = G * 8;
        f32x4 g4[4], b4[4];
#pragma unroll
        for (int j = 0; j < 4; ++j) { g4[j] = *(const f32x4*)(a.ln2_g + 4 * lane + 256 * j); b4[j] = *(const f32x4*)(a.ln2_b + 4 * lane + 256 * j); }
        const unsigned tmo = __hip_atomic_load(ctl + CW_BAR + XB_TMO, RLX_AGENT);
        for (int m = gw; m < T; m += NGW) {
            const GAS v2u* hp = (const GAS v2u*)(HB + (size_t)m * D) + lane; const GAS v2u* y0 = (const GAS v2u*)(Y + (size_t)m * 2 * D) + lane; const GAS v2u* y1 = y0 + 256;
            f32x4 v[4]; float s = 0.f;
#pragma unroll
            for (int j = 0; j < 4; ++j) { const v2u hw = hp[64 * j], ya = y0[64 * j], yb = y1[64 * j];
                v[j].x = ALPHA * bf_lo(hw.x) + bf_lo(ya.x) + bf_lo(yb.x); v[j].y = ALPHA * bf_hi(hw.x) + bf_hi(ya.x) + bf_hi(yb.x);
                v[j].z = ALPHA * bf_lo(hw.y) + bf_lo(ya.y) + bf_lo(yb.y); v[j].w = ALPHA * bf_hi(hw.y) + bf_hi(ya.y) + bf_hi(yb.y);
                s += (v[j].x + v[j].y) + (v[j].z + v[j].w); }
            const float mean = wave_sum(s) * (1.f / D); float s2 = 0.f;
#pragma unroll
            for (int j = 0; j < 4; ++j) { v[j] = v[j] - mean; s2 += (v[j].x * v[j].x + v[j].y * v[j].y) + (v[j].z * v[j].z + v[j].w * v[j].w); }
            float rstd = 1.f / sqrtf(wave_sum(s2) * (1.f / D) + LN_EPS);
            if (tmo) rstd = __builtin_nanf("");
            GAS f32x4* op = (GAS f32x4*)(a.out + (size_t)m * D) + lane;
#pragma unroll
            for (int j = 0; j < 4; ++j) op[64 * j] = v[j] * rstd * g4[j] + b4[j];
        }
    }
#undef IN
#undef SEAM
}

extern "C" void kernel_launch(void* const* d_in, const int* in_sizes, int n_in, void* d_out, int out_size, void* d_ws, size_t ws_size, hipStream_t stream) {
    static int grid = 0;
    if (grid == 0) {
        if (n_in != 25 || in_sizes[0] != T * D || out_size != T * D || ws_size < WS_END) { fprintf(stderr, "kernel_launch: unexpected shapes (n_in %d, in0 %d, out %d, ws %zu)\n", n_in, n_in > 0 ? in_sizes[0] : -1, out_size, ws_size); grid = -1; return; }
        int dev = 0, cus = 0, per_cu = 0;
        if (hipGetDevice(&dev) != hipSuccess || hipDeviceGetAttribute(&cus, hipDeviceAttributeMultiprocessorCount, dev) != hipSuccess) { grid = -1; return; }
        if (hipFuncSetAttribute((const void*)fwd_kernel, hipFuncAttributeMaxDynamicSharedMemorySize, LDS_BYTES) != hipSuccess) { fprintf(stderr, "kernel_launch: hipFuncSetAttribute failed\n"); grid = -1; return; }
        if (hipOccupancyMaxActiveBlocksPerMultiprocessor(&per_cu, (const void*)fwd_kernel, 512, LDS_BYTES) != hipSuccess || per_cu < 1) fprintf(stderr, "kernel_launch: occupancy query reports %d\n", per_cu);
        (void)hipGetLastError();
        grid = cus;
    }
    if (grid < 0) return;
    (void)hipMemsetAsync((char*)d_ws + WS_CTL, 0, CTL_ZERO_BYTES, stream);
    Args a{};
    a.x = (const float*)d_in[0]; a.pos = (const int*)d_in[1]; a.ln_in_g = (const float*)d_in[2]; a.ln_in_b = (const float*)d_in[3]; a.w_in = (const float*)d_in[4];
    a.lam_q1 = (const float*)d_in[5]; a.lam_k1 = (const float*)d_in[6]; a.lam_q2 = (const float*)d_in[7]; a.lam_k2 = (const float*)d_in[8]; a.subln_g = (const float*)d_in[9];
    a.wg2 = (const float*)d_in[10]; a.bg2 = (const float*)d_in[11]; a.gla_norm_g = (const float*)d_in[12]; a.w_o = (const float*)d_in[13]; a.ln1_g = (const float*)d_in[14]; a.ln1_b = (const float*)d_in[15];
    a.w_rg = (const float*)d_in[16]; a.b_rg = (const float*)d_in[17]; a.w_re = (const float*)d_in[18]; a.b_re = (const float*)d_in[19];
    a.w_gate = (const float*)d_in[20]; a.w_up = (const float*)d_in[21]; a.w_down = (const float*)d_in[22]; a.ln2_g = (const float*)d_in[23]; a.ln2_b = (const float*)d_in[24];
    a.out = (float*)d_out; a.ws = (unsigned char*)d_ws;
#if MK_SPLIT
    for (int p = 0; p < NPH; ++p) { a.ph_lo = p; a.ph_hi = p + 1; hipLaunchKernelGGL(fwd_kernel, dim3(grid), dim3(512), LDS_BYTES, stream, a); }
#else
    a.ph_lo = 0; a.ph_hi = NPH;
    hipLaunchKernelGGL(fwd_kernel, dim3(grid), dim3(512), LDS_BYTES, stream, a);
#endif
}
```

```cpp
#include <hip/hip_runtime.h>
#include <cstdio>
#include <cstdint>

#ifndef MK_SPLIT
#define MK_SPLIT 0
#endif

#define GAS __attribute__((address_space(1)))
#define LAS __attribute__((address_space(3)))
typedef unsigned short bf16;
typedef unsigned v4u __attribute__((ext_vector_type(4)));
typedef unsigned v2u __attribute__((ext_vector_type(2)));
typedef float f32x4 __attribute__((ext_vector_type(4)));
typedef float f32x2 __attribute__((ext_vector_type(2)));
typedef float f32x16 __attribute__((ext_vector_type(16)));
typedef short bf16x8 __attribute__((ext_vector_type(8)));
typedef short s16x4 __attribute__((ext_vector_type(4)));
typedef short v4i16_t __attribute__((ext_vector_type(4)));

constexpr int T = 16384, D = 1024, NB = 8, SEQ = 2048;
constexpr int NPROJ = 3072;
constexpr int WIN_LD = 3088;
constexpr int C_DQ = 0, C_GO = 512, C_DK = 1024, C_DV = 1536, C_GQ = 2048, C_GK = 2304, C_GV = 2560;
constexpr int NEXP = 32, DE = 512, LCAP = 16384;
constexpr float LN_EPS = 1e-5f;
constexpr float ALPHA = 1.189207115002721f;
constexpr float C2 = 0.125f * 1.4426950408889634f;
constexpr float LAM_INIT = 0.2f;

constexpr size_t MiB = 1u << 20;
constexpr size_t WS_CTL = 0, CTL_ZERO_BYTES = 1 * MiB;
constexpr size_t WS_STATS = 1 * MiB;
constexpr size_t WS_GLOW = 2 * MiB;
constexpr size_t WS_ROPE = 4 * MiB;
constexpr size_t WS_LTOK = 8 * MiB;
constexpr size_t WS_LW = 10 * MiB;
constexpr size_t WS_DEC = 12 * MiB;
constexpr size_t WS_WRT = 13 * MiB;
constexpr size_t WS_WIN = 16 * MiB;
constexpr size_t WS_WO = 22 * MiB;
constexpr size_t WS_WGU = 24 * MiB;
constexpr size_t WS_WD = 88 * MiB;
constexpr size_t WS_A = 120 * MiB;
constexpr size_t WS_HB = WS_A, WS_Y = WS_A + 32 * MiB;
constexpr size_t WS_B = 216 * MiB;
constexpr size_t WS_DS = WS_B, WS_SP = WS_B + 16 * MiB;
constexpr size_t WS_END = 256 * MiB;
constexpr int CW_TMO = 0, CW_BAR = 4096, CW_CNT = 8192;

constexpr int SCR_BYTES = 153600;
constexpr int LDSCTL_OFF = SCR_BYTES;
constexpr int LDS_BYTES = SCR_BYTES + 1024;

#define RLX_AGENT __ATOMIC_RELAXED, __HIP_MEMORY_SCOPE_AGENT
#define LDS_WAIT() asm volatile("s_waitcnt lgkmcnt(0)" ::: "memory")
#define VM_WAIT() asm volatile("s_waitcnt vmcnt(0)" ::: "memory")
typedef __bf16 bf16x2_t __attribute__((ext_vector_type(2)));
__device__ __forceinline__ unsigned cvt_pk_bf16(float lo, float hi) { const f32x2 v = {lo, hi}; const bf16x2_t b = __builtin_convertvector(v, bf16x2_t); return __builtin_bit_cast(unsigned, b); }
__device__ __forceinline__ float bf_lo(unsigned u) { return __uint_as_float(u << 16); }
__device__ __forceinline__ float bf_hi(unsigned u) { return __uint_as_float(u & 0xffff0000u); }
__device__ __forceinline__ float wave_sum(float v) {
#pragma unroll
    for (int o = 1; o < 64; o <<= 1) v += __shfl_xor(v, o);
    return v;
}
__device__ __forceinline__ float ex2(float x) { return __builtin_amdgcn_exp2f(x); }
__device__ __forceinline__ int crow(int r, int hi) { return (r & 3) + 8 * (r >> 2) + 4 * hi; }
template <int N> __device__ __forceinline__ void reduce_scatter(float (&v)[N], int lane) {
    int off = 32;
#pragma unroll
    for (int n = N; n > 1; n >>= 1) {
        const int half = n >> 1; const bool up = (lane & off) != 0;
#pragma unroll
        for (int i = 0; i < half; ++i) { const float send = up ? v[i] : v[i + half]; const float keep = up ? v[i + half] : v[i]; v[i] = keep + __shfl_xor(send, off); }
        off >>= 1;
    }
    for (; off >= 1; off >>= 1) v[0] += __shfl_xor(v[0], off);
}

namespace pg8 {
constexpr int BM = 256, BK = 64, HALF = 128, HTB = HALF * BK * 2, STAGE_BYTES = 8 * HTB, NXCD = 8, WGM = 8;
__host__ __device__ __forceinline__ int lds_byte(int r, int c) { const int st = (r >> 4) * 2 + (c >> 5), rr = r & 15, cc = c & 31, ob = rr * 64 + cc * 2; return st * 1024 + (ob ^ (((ob >> 9) & 1) << 5)); }
__host__ __device__ __forceinline__ void stage_rc(int b, int& R, int& C) { const int st = b / 1024, sb = b % 1024, swz = sb ^ (((sb >> 9) & 1) << 5); R = (st >> 1) * 16 + swz / 64; C = (st & 1) * 32 + (swz % 64) / 2; }
__host__ __device__ __forceinline__ int perm32(int rho) { const int n = rho >> 4, i = rho & 15; return 8 * (i >> 2) + 4 * n + (i & 3); }

struct Unit { const char* A; const char* B; unsigned va00, va01, va10, va11; int pm, pn, e, r0, cnt; };

template <class Epi, class Sched, bool ALIGN_EPI>
__device__ __forceinline__ void gemm_phase(LAS unsigned char* lds, const int K, const Sched& S, const Epi& E) {
    const int tid = threadIdx.x, wid = __builtin_amdgcn_readfirstlane(tid >> 6), lane = tid & 63, wr = wid >> 2, wc = wid & 3, fr = lane & 15, fq = lane >> 4;
    const int nt = K / BK;
    unsigned voffB[2];
#pragma unroll
    for (int i = 0; i < 2; ++i) { int R, C; stage_rc(tid * 16 + i * 8192, R, C); const int Rb = Epi::PERM ? ((R & ~31) + perm32(R & 31)) : R; voffB[i] = (unsigned)(Rb * K + C) * 2u; }
    const size_t kstep = (size_t)(BK * 2);
    const size_t hstep = (size_t)HALF * K * 2;
    const unsigned ldsw = (unsigned)wid * 1024u;
    const int aoff = lds_byte(wr * 64 + fr, fq * 8), boff = lds_byte(wc * 32 + fr, fq * 8);
#define PG8_SA(b, h) (((b) * 2 + (h)) * HTB)
#define PG8_SB(b, h) ((4 + (b) * 2 + (h)) * HTB)
#define PG8_STAGE2(bufoff, gbase, v0, v1) do { \
        __builtin_amdgcn_global_load_lds((const unsigned*)((const char*)(gbase) + (v0)), (LAS unsigned*)(lds + (bufoff) + ldsw), 16, 0, 0); \
        __builtin_amdgcn_global_load_lds((const unsigned*)((const char*)(gbase) + (v1)), (LAS unsigned*)(lds + (bufoff) + ldsw + 8192), 16, 0, 0); } while (0)
#define PG8_STAGE(bufoff, gbase, voff) PG8_STAGE2(bufoff, gbase, (voff)[0], (voff)[1])
#define PG8_LDA(dst, b, h) do { _Pragma("unroll") for (int m = 0; m < 4; ++m) _Pragma("unroll") for (int k = 0; k < 2; ++k) dst[m][k] = *(const LAS bf16x8*)(lds + PG8_SA(b, h) + aoff + m * 2048 + k * 1024); } while (0)
#define PG8_LDB(dst, b, h) do { _Pragma("unroll") for (int n = 0; n < 2; ++n) _Pragma("unroll") for (int k = 0; k < 2; ++k) dst[n][k] = *(const LAS bf16x8*)(lds + PG8_SB(b, h) + boff + n * 2048 + k * 1024); } while (0)
#define PG8_MMA(ai, bj, At, Bt) do { __builtin_amdgcn_s_setprio(1); _Pragma("unroll") for (int m = 0; m < 4; ++m) _Pragma("unroll") for (int n = 0; n < 2; ++n) _Pragma("unroll") for (int k = 0; k < 2; ++k) \
        acc[ai][bj][m][n] = __builtin_amdgcn_mfma_f32_16x16x32_bf16(Bt[n][k], At[m][k], acc[ai][bj][m][n], 0, 0, 0); __builtin_amdgcn_s_setprio(0); } while (0)
#define PG8_WAIT_V(n) asm volatile("s_waitcnt vmcnt(" #n ")" ::: "memory")
#define PG8_WAIT_L(n) asm volatile("s_waitcnt lgkmcnt(" #n ")" ::: "memory")
#define PG8_BAR __builtin_amdgcn_s_barrier()
#define PG8_SCHED __builtin_amdgcn_sched_barrier(0)
    Unit cur, nxt; int ui = 0;
    if (!S.next(0, cur)) return;
    f32x4 acc[2][2][4][2];
#pragma unroll
    for (int a = 0; a < 2; ++a)
#pragma unroll
        for (int b = 0; b < 2; ++b)
#pragma unroll
            for (int m = 0; m < 4; ++m)
#pragma unroll
                for (int n = 0; n < 2; ++n) acc[a][b][m][n] = (f32x4){0.f, 0.f, 0.f, 0.f};
    bf16x8 At[4][2], B0[2][2], B1[2][2];
    const char* cA = cur.A; const char* cB = cur.B;
    PG8_STAGE(PG8_SB(0, 0), cB, voffB); PG8_STAGE(PG8_SB(0, 1), cB + hstep, voffB); PG8_STAGE2(PG8_SA(0, 0), cA, cur.va00, cur.va01); PG8_STAGE2(PG8_SA(0, 1), cA, cur.va10, cur.va11);
    if (wr == 1) PG8_BAR;
    PG8_WAIT_V(2); PG8_BAR;
    PG8_STAGE(PG8_SB(1, 0), cB + kstep, voffB); PG8_STAGE2(PG8_SA(1, 0), cA + kstep, cur.va00, cur.va01); PG8_STAGE(PG8_SB(1, 1), cB + hstep + kstep, voffB);
    PG8_WAIT_V(6); PG8_BAR;
    for (;;) {
        const bool has_next = S.next(ui + 1, nxt);
        const char* nA = has_next ? nxt.A : cA; const char* nB = has_next ? nxt.B : cB;
        const unsigned n00 = has_next ? nxt.va00 : cur.va00, n01 = has_next ? nxt.va01 : cur.va01, n10 = has_next ? nxt.va10 : cur.va10, n11 = has_next ? nxt.va11 : cur.va11;
        for (int t = 0; t < nt; t += 2) {
            const bool last = (t == nt - 2);
            const char* a1 = cA + (size_t)(t + 1) * kstep;
            const char* a2 = last ? nA : cA + (size_t)(t + 2) * kstep; const char* b2 = last ? nB : cB + (size_t)(t + 2) * kstep;
            const char* a3 = a2 + kstep; const char* b3 = b2 + kstep;
            const unsigned w00 = last ? n00 : cur.va00, w01 = last ? n01 : cur.va01, w10 = last ? n10 : cur.va10, w11 = last ? n11 : cur.va11;
            PG8_LDB(B0, 0, 0); PG8_LDB(B1, 0, 1); PG8_SCHED; PG8_LDA(At, 0, 0); PG8_STAGE2(PG8_SA(1, 1), a1, cur.va10, cur.va11);
            PG8_WAIT_V(8); PG8_WAIT_L(0); PG8_BAR; PG8_MMA(0, 0, At, B0); PG8_MMA(0, 1, At, B1); PG8_BAR; PG8_SCHED;
            PG8_LDA(At, 0, 1); PG8_STAGE(PG8_SB(0, 0), b2, voffB); PG8_STAGE(PG8_SB(0, 1), b2 + hstep, voffB); PG8_STAGE2(PG8_SA(0, 0), a2, w00, w01);
            PG8_WAIT_V(8); PG8_WAIT_L(0); PG8_BAR; PG8_MMA(1, 0, At, B0); PG8_MMA(1, 1, At, B1); PG8_BAR; PG8_SCHED;
            PG8_LDB(B0, 1, 0); PG8_LDB(B1, 1, 1); PG8_SCHED; PG8_LDA(At, 1, 0); PG8_STAGE2(PG8_SA(0, 1), a2, w10, w11);
            PG8_WAIT_V(8); PG8_WAIT_L(0); PG8_BAR; PG8_MMA(0, 0, At, B0); PG8_MMA(0, 1, At, B1); PG8_BAR; PG8_SCHED;
            PG8_LDA(At, 1, 1); PG8_STAGE(PG8_SB(1, 0), b3, voffB); PG8_STAGE(PG8_SB(1, 1), b3 + hstep, voffB); PG8_STAGE2(PG8_SA(1, 0), a3, w00, w01);
            PG8_WAIT_V(8); PG8_WAIT_L(0); PG8_BAR; PG8_MMA(1, 0, At, B0); PG8_MMA(1, 1, At, B1); PG8_BAR; PG8_SCHED;
        }
        if constexpr (ALIGN_EPI) { if (wr == 0) PG8_BAR; }
        E(acc, cur, wr, wc, fr, fq);
        if (!has_next) break;
#pragma unroll
        for (int a = 0; a < 2; ++a)
#pragma unroll
            for (int b = 0; b < 2; ++b)
#pragma unroll
                for (int m = 0; m < 4; ++m)
#pragma unroll
                    for (int n = 0; n < 2; ++n) acc[a][b][m][n] = (f32x4){0.f, 0.f, 0.f, 0.f};
        cur = nxt; cA = nA; cB = nB; ++ui;
        if constexpr (ALIGN_EPI) { if (wr == 1) PG8_BAR; }
    }
    PG8_WAIT_V(0);
    if constexpr (!ALIGN_EPI) { if (wr == 0) PG8_BAR; }
    PG8_BAR;
#undef PG8_SA
#undef PG8_SB
#undef PG8_STAGE
#undef PG8_STAGE2
#undef PG8_LDA
#undef PG8_LDB
#undef PG8_MMA
#undef PG8_WAIT_V
#undef PG8_WAIT_L
#undef PG8_BAR
#undef PG8_SCHED
}

struct DenseOrder {
    const char* A; const char* B; int lda, K, nM, nN, nwg, G, c;
    __device__ __forceinline__ void init(const void* A_, int lda_, const void* B_, int K_, int M, int N, int G_, int c_) { A = (const char*)A_; B = (const char*)B_; lda = lda_; K = K_; nM = M / BM; nN = N / BM; nwg = nM * nN; G = G_; c = c_; }
    __device__ __forceinline__ bool next(int i, Unit& u) const {
        const long L = (long)i * G + c; if (L >= nwg) return false;
        int wgid = (int)L; { const int q = nwg / NXCD, r = nwg % NXCD, xcd = wgid % NXCD, off = wgid / NXCD; wgid = (xcd < r ? xcd * (q + 1) : r * (q + 1) + (xcd - r) * q) + off; }
        const int nig = WGM * nN, gid = wgid / nig, fm = gid * WGM, gsz = (nM - fm) < WGM ? (nM - fm) : WGM;
        u.pm = fm + ((wgid % nig) % gsz); u.pn = (wgid % nig) / gsz; u.e = 0; u.r0 = 0; u.cnt = 0;
        u.A = A + (size_t)u.pm * BM * lda * 2; u.B = B + (size_t)u.pn * BM * K * 2;
        const int tid = threadIdx.x; int R0, C0, R1, C1; stage_rc(tid * 16, R0, C0); stage_rc(tid * 16 + 8192, R1, C1);
        u.va00 = (unsigned)(R0 * lda + C0) * 2u; u.va01 = (unsigned)(R1 * lda + C1) * 2u; u.va10 = (unsigned)((HALF + R0) * lda + C0) * 2u; u.va11 = (unsigned)((HALF + R1) * lda + C1) * 2u;
        return true;
    }
};
}

#define XB_TMO      128
#define XB_XCNT(j)  (256  + 64 * (j))
#define XB_XSUB(j)  (1280 + 64 * (j))
#define XB_XGEN(j)  (2304 + 64 * (j))
#define XB_TOP      3328
#define XB_TOPGEN   3392
#define XCD_BAR_WORDS 3456
#define XB_SPIN_CAP (1u << 18)
__device__ __forceinline__ unsigned xb_ld(unsigned* p)              { return __hip_atomic_load(p, __ATOMIC_RELAXED, __HIP_MEMORY_SCOPE_AGENT); }
__device__ __forceinline__ unsigned xb_add(unsigned* p, unsigned v) { return __hip_atomic_fetch_add(p, v, __ATOMIC_RELAXED, __HIP_MEMORY_SCOPE_AGENT); }
__device__ __forceinline__ unsigned xb_xcc_id() { return (unsigned)__builtin_amdgcn_s_getreg((3 << 11) | 20) & 0xFu; }
#define XB_SPIN(cond, bar) do { unsigned _sp = 0; while (cond) { __builtin_amdgcn_s_sleep(1); \
    if ((++_sp & 255u) == 0u) { if (xb_ld(&(bar)[XB_TMO])) break; if (_sp > XB_SPIN_CAP) { atomicAdd(&(bar)[XB_TMO], 1u); break; } } } } while (0)
struct XcdBarrier { unsigned* bar; unsigned x; volatile LAS unsigned* st; };
__device__ __forceinline__ XcdBarrier xcd_barrier_post(unsigned* bar, volatile LAS unsigned* st) {
    XcdBarrier b; b.bar = bar; b.x = xb_xcc_id(); b.st = st;
    if (threadIdx.x == 0) (void)xb_add(&bar[XB_XCNT(b.x)], 1u);
    return b;
}
__device__ __forceinline__ void xcd_barrier_complete(unsigned* bar, unsigned x, unsigned& nloc, unsigned& nx) {
    const unsigned G = gridDim.x * gridDim.y * gridDim.z;
    unsigned sum, cnt, mine, sp = 0u;
    for (;;) {
        sum = 0u; cnt = 0u; mine = 0u;
#pragma unroll
        for (unsigned j = 0; j < 16; ++j) { const unsigned c = xb_ld(&bar[XB_XCNT(j)]); sum += c; cnt += (c > 0u) ? 1u : 0u; mine = (j == x) ? c : mine; }
        if (sum == G) break;
        __builtin_amdgcn_s_sleep(1);
        if ((++sp & 255u) == 0u) { if (xb_ld(&bar[XB_TMO])) break; if (sp > XB_SPIN_CAP) { atomicAdd(&bar[XB_TMO], 1u); break; } }
    }
    nloc = mine > 0u ? mine : 1u; nx = cnt > 0u ? cnt : 1u;
}
__device__ __forceinline__ void xcd_barrier(const XcdBarrier& b) {
    asm volatile("s_waitcnt vmcnt(0)" ::: "memory");
    __syncthreads();
    if (threadIdx.x == 0) {
        unsigned* bar = b.bar;
        __builtin_amdgcn_s_waitcnt(0);
        unsigned nloc = b.st[0], nx = b.st[1];
        if (nloc == 0u) { xcd_barrier_complete(bar, b.x, nloc, nx); b.st[0] = nloc; b.st[1] = nx; }
        const unsigned old = xb_add(&bar[XB_XSUB(b.x)], 1u);
        const unsigned gen = old / nloc;
        if (old + 1u == (gen + 1u) * nloc) {
            __builtin_amdgcn_fence(__ATOMIC_RELEASE, "agent");
            asm volatile("s_waitcnt vmcnt(0)" ::: "memory");
            const unsigned og = xb_add(&bar[XB_TOP], 1u);
            const unsigned tg = og / nx;
            if (og + 1u == (tg + 1u) * nx) xb_add(&bar[XB_TOPGEN], 1u);
            else XB_SPIN(xb_ld(&bar[XB_TOPGEN]) == tg, bar);
            __builtin_amdgcn_fence(__ATOMIC_ACQUIRE, "agent");
            xb_add(&bar[XB_XGEN(b.x)], 1u);
            asm volatile("s_waitcnt vmcnt(0)" ::: "memory");
        } else {
            XB_SPIN(xb_ld(&bar[XB_XGEN(b.x)]) == gen, bar);
            __builtin_amdgcn_fence(__ATOMIC_ACQUIRE, "agent");
            asm volatile("s_waitcnt vmcnt(0)" ::: "memory");
        }
    }
    __syncthreads();
}

struct Args {
    const float* x; const int* pos; const float* ln_in_g; const float* ln_in_b; const float* w_in;
    const float* lam_q1; const float* lam_k1; const float* lam_q2; const float* lam_k2; const float* subln_g;
    const float* wg2; const float* bg2; const float* gla_norm_g; const float* w_o; const float* ln1_g; const float* ln1_b;
    const float* w_rg; const float* b_rg; const float* w_re; const float* b_re; const float* w_gate; const float* w_up; const float* w_down;
    const float* ln2_g; const float* ln2_b;
    float* out; unsigned char* ws; int ph_lo, ph_hi;
};

struct TItem { const float* src; bf16* dst; int ldw, ldt; };
__device__ __forceinline__ void p0_item_load(const TItem& t, f32x4 (&v)[16], int lane) {
    const float* src = t.src + (size_t)(lane >> 4) * t.ldw + 4 * (lane & 15);
#pragma unroll
    for (int i = 0; i < 16; ++i) v[i] = *(const f32x4*)(src + (size_t)(4 * i) * t.ldw);
}
__device__ __forceinline__ void p0_item_finish(const TItem& t, const f32x4 (&v)[16], LAS float* scr, int lane) {
    LAS float* d = scr + (lane >> 4) * 65 + 4 * (lane & 15);
#pragma unroll
    for (int i = 0; i < 16; ++i) { d[(4 * i) * 65 + 0] = v[i].x; d[(4 * i) * 65 + 1] = v[i].y; d[(4 * i) * 65 + 2] = v[i].z; d[(4 * i) * 65 + 3] = v[i].w; }
    LDS_WAIT(); asm volatile("" ::: "memory");
    const int c = lane & 7;
#pragma unroll
    for (int j = 0; j < 8; ++j) { const int n = (lane >> 3) + 8 * j; const LAS float* s = scr + (8 * c) * 65 + n;
        v4u o; o.x = cvt_pk_bf16(s[0 * 65], s[1 * 65]); o.y = cvt_pk_bf16(s[2 * 65], s[3 * 65]); o.z = cvt_pk_bf16(s[4 * 65], s[5 * 65]); o.w = cvt_pk_bf16(s[6 * 65], s[7 * 65]);
        *(GAS v4u*)(t.dst + (size_t)n * t.ldt + 8 * c) = o; }
    LDS_WAIT(); asm volatile("" ::: "memory");
}
__device__ __forceinline__ TItem p0_item_decode(const Args& a, int it) {
    constexpr int I_IN = 16 * 48, I_O = 16 * 16, I_G = 32 * 128, I_U = 32 * 128;
    unsigned char* ws = a.ws; bf16* WIN = (bf16*)(ws + WS_WIN); bf16* WO = (bf16*)(ws + WS_WO); bf16* WGU = (bf16*)(ws + WS_WGU); bf16* WD = (bf16*)(ws + WS_WD);
    TItem t; int r = it;
    if (r < I_IN) { const int kb = r / 48, nb = r % 48, n0 = 64 * nb, sb = n0 >> 9;
        const int dmap = (sb == 0) ? C_DQ : (sb == 1) ? C_DK : (sb == 2) ? C_DV : (sb == 3) ? C_GQ : (sb == 4) ? C_GV : C_GO;
        t.src = a.w_in + (size_t)(64 * kb) * WIN_LD + n0; t.ldw = WIN_LD; t.dst = WIN + (size_t)(dmap + (n0 & 511)) * 1024 + 64 * kb; t.ldt = 1024; return t; }
    r -= I_IN;
    if (r < I_O) { const int kb = r / 16, nb = r % 16; t.src = a.w_o + (size_t)(64 * kb) * 1024 + 64 * nb; t.ldw = 1024; t.dst = WO + (size_t)(64 * nb) * 1024 + 64 * kb; t.ldt = 1024; return t; }
    r -= I_O;
    if (r < I_G + I_U) { const bool up = r >= I_G; if (up) r -= I_G; const int e = r >> 7, q = r & 127, kb = q >> 3, nb = q & 7, n0 = 64 * nb;
        t.src = (up ? a.w_up : a.w_gate) + (size_t)e * 1024 * 512 + (size_t)(64 * kb) * 512 + n0; t.ldw = 512;
        t.dst = WGU + (size_t)e * 1024 * 1024 + (size_t)(256 * (n0 >> 7) + (n0 & 127) + (up ? 128 : 0)) * 1024 + 64 * kb; t.ldt = 1024; return t; }
    r -= I_G + I_U;
    { const int e = r >> 7, q = r & 127, kb = q >> 4, nb = q & 15;
      t.src = a.w_down + (size_t)e * 512 * 1024 + (size_t)(64 * kb) * 1024 + 64 * nb; t.ldw = 1024; t.dst = WD + (size_t)e * 1024 * 512 + (size_t)(64 * nb) * 512 + 64 * kb; t.ldt = 512; return t; }
}

template <int RT, int RR, int RL>
__device__ __forceinline__ void phase0(const Args& a, LAS unsigned char* lds, int vcu, int G, int tid, int lane, int wave) {
    unsigned char* ws = a.ws;
    LAS float* scr = (LAS float*)(lds + wave * 16640);
    const int gw = vcu * 8 + wave, NGW = G * 8, bx0 = vcu;
    constexpr int NITEMS = 16 * 48 + 16 * 16 + 3 * 32 * 128;
#pragma unroll
    for (int rep = 0; rep < RT; ++rep) {
        f32x4 va[16], vb[16]; TItem ta, tb; int it = gw;
        if (it < NITEMS) { ta = p0_item_decode(a, it); p0_item_load(ta, va, lane); }
        while (it < NITEMS) {
            const int itn = it + NGW;
            if (itn < NITEMS) { tb = p0_item_decode(a, itn); p0_item_load(tb, vb, lane); }
            p0_item_finish(ta, va, scr, lane);
            ta = tb;
#pragma unroll
            for (int i = 0; i < 16; ++i) va[i] = vb[i];
            it = itn;
        }
    }
    __syncthreads();
#pragma unroll
    for (int rep = 0; rep < RR; ++rep) {
        f32x2* rope = (f32x2*)(ws + WS_ROPE);
        for (int idx = (vcu * 512 + tid); idx < T * 32; idx += G * 512) {
            const int tt = idx >> 5, i = idx & 31;
            const float invf = (float)exp(-(double)i * (9.210340371976184 / 32.0));
            const float ang = (float)a.pos[tt] * invf;
            const double ad = (double)ang; const double kq = rint(ad * 0.15915494309189535);
            double r = fma(-kq, 6.283185307179586, ad); r = fma(-kq, 2.4492935982947064e-16, r);
            const double z = r * r;
            double s = 1.0 / 51090942171709440000.0;
            s = fma(s, z, -1.0 / 121645100408832000.0); s = fma(s, z, 1.0 / 355687428096000.0); s = fma(s, z, -1.0 / 1307674368000.0); s = fma(s, z, 1.0 / 6227020800.0);
            s = fma(s, z, -1.0 / 39916800.0); s = fma(s, z, 1.0 / 362880.0); s = fma(s, z, -1.0 / 5040.0); s = fma(s, z, 1.0 / 120.0); s = fma(s, z, -1.0 / 6.0); s = fma(s, z, 1.0);
            s *= r;
            double c = -1.0 / 1124000727777607680000.0;
            c = fma(c, z, 1.0 / 2432902008176640000.0); c = fma(c, z, -1.0 / 6402373705728000.0); c = fma(c, z, 1.0 / 20922789888000.0); c = fma(c, z, -1.0 / 87178291200.0);
            c = fma(c, z, 1.0 / 479001600.0); c = fma(c, z, -1.0 / 3628800.0); c = fma(c, z, 1.0 / 40320.0); c = fma(c, z, -1.0 / 720.0); c = fma(c, z, 1.0 / 24.0); c = fma(c, z, -0.5); c = fma(c, z, 1.0);
            rope[idx] = (f32x2){(float)c, (float)s};
        }
    }
    { bf16* WRT = (bf16*)(ws + WS_WRT);
      for (int idx = vcu * 512 + tid; idx < 48 * 1024; idx += G * 512) { const int c = idx >> 10, k = idx & 1023;
          const float w = (c < 4) ? a.w_rg[k * 4 + c] : (c < 36) ? a.w_re[k * 32 + (c - 4)] : 0.f;
          const unsigned hi = cvt_pk_bf16(w, 0.f) & 0xffffu; const unsigned lo = cvt_pk_bf16(w - bf_lo(hi), 0.f) & 0xffffu;
          WRT[idx] = (bf16)hi; WRT[48 * 1024 + idx] = (bf16)lo; } }
#pragma unroll
    for (int rep = 0; rep < RL; ++rep) {
        bf16* XN = (bf16*)(ws + WS_B); float* stats = (float*)(ws + WS_STATS); float* glow = (float*)(ws + WS_GLOW);
        LAS float* red = (LAS float*)(lds + 33024);
        bf16x8 wf[4];
#pragma unroll
        for (int sk = 0; sk < 4; ++sk) { const float* wp = a.w_in + (size_t)(128 * wave + 32 * sk + 8 * (lane >> 4)) * WIN_LD + NPROJ + (lane & 15);
            v4u w; w.x = cvt_pk_bf16(wp[0], wp[WIN_LD]); w.y = cvt_pk_bf16(wp[2 * WIN_LD], wp[3 * WIN_LD]); w.z = cvt_pk_bf16(wp[4 * WIN_LD], wp[5 * WIN_LD]); w.w = cvt_pk_bf16(wp[6 * WIN_LD], wp[7 * WIN_LD]);
            wf[sk] = __builtin_bit_cast(bf16x8, w); }
        const int ngrp = T / 16;
        f32x4 vn[2][4];
        { const int g0 = bx0; if (g0 < ngrp) {
#pragma unroll
            for (int q = 0; q < 2; ++q) { const GAS f32x4* xr = (const GAS f32x4*)(a.x + ((size_t)g0 * 16 + 2 * wave + q) * D) + lane;
#pragma unroll
                for (int j = 0; j < 4; ++j) vn[q][j] = xr[64 * j]; } } }
        for (int grp = bx0; grp < ngrp; grp += G) {
            f32x4 v[2][4];
#pragma unroll
            for (int q = 0; q < 2; ++q)
#pragma unroll
                for (int j = 0; j < 4; ++j) v[q][j] = vn[q][j];
            if (grp + G < ngrp) {
#pragma unroll
                for (int q = 0; q < 2; ++q) { const GAS f32x4* xr = (const GAS f32x4*)(a.x + ((size_t)(grp + G) * 16 + 2 * wave + q) * D) + lane;
#pragma unroll
                    for (int j = 0; j < 4; ++j) vn[q][j] = xr[64 * j]; } }
#pragma unroll
            for (int q = 0; q < 2; ++q) {
                const int rl = 2 * wave + q; const size_t m = (size_t)grp * 16 + rl;
                float s = 0.f;
#pragma unroll
                for (int j = 0; j < 4; ++j) s += (v[q][j].x + v[q][j].y) + (v[q][j].z + v[q][j].w);
                const float mean = wave_sum(s) * (1.f / D); float s2 = 0.f;
#pragma unroll
                for (int j = 0; j < 4; ++j) { v[q][j] = v[q][j] - mean; s2 += (v[q][j].x * v[q][j].x + v[q][j].y * v[q][j].y) + (v[q][j].z * v[q][j].z + v[q][j].w * v[q][j].w); }
                const float rstd = 1.f / sqrtf(wave_sum(s2) * (1.f / D) + LN_EPS);
                if (lane == 0) *(f32x2*)(stats + 2 * m) = (f32x2){mean, rstd};
                GAS v2u* o8 = (GAS v2u*)(XN + m * D) + lane;
#pragma unroll
                for (int j = 0; j < 4; ++j) {
                    const f32x4 y = v[q][j] * rstd * *(const f32x4*)(a.ln_in_g + 4 * lane + 256 * j) + *(const f32x4*)(a.ln_in_b + 4 * lane + 256 * j);
                    v2u w; w.x = cvt_pk_bf16(y.x, y.y); w.y = cvt_pk_bf16(y.z, y.w); o8[64 * j] = w;
                    *(LAS v2u*)(lds + rl * 2064 + (4 * lane + 256 * j) * 2) = w;
                }
            }
            __syncthreads();
            { f32x4 acc = (f32x4){0.f, 0.f, 0.f, 0.f};
#pragma unroll
              for (int sk = 0; sk < 4; ++sk) { const bf16x8 af = *(const LAS bf16x8*)(lds + (lane & 15) * 2064 + (128 * wave + 32 * sk + 8 * (lane >> 4)) * 2);
                  acc = __builtin_amdgcn_mfma_f32_16x16x32_bf16(af, wf[sk], acc, 0, 0, 0); }
#pragma unroll
              for (int r = 0; r < 4; ++r) red[(wave * 4 + r) * 64 + lane] = acc[r]; }
            __syncthreads();
            if (tid < 256) { const int row = tid >> 4, col = tid & 15, ls = col + 16 * (row >> 2), r = row & 3; float sum = 0.f;
#pragma unroll
                for (int w = 0; w < 8; ++w) sum += red[(w * 4 + r) * 64 + ls];
                glow[((size_t)grp * 16 + row) * 16 + col] = sum; }
        }
        __syncthreads();
    }
}

struct EpiProj {
    static constexpr bool PERM = true;
    bf16* O; const float* rope;
    __device__ __forceinline__ void operator()(const f32x4 (&acc)[2][2][4][2], const pg8::Unit& u, int wr, int wc, int fr, int fq) const {
        const int pn = u.pn; const bool dorope = (pn < 2) || (pn == 4) || (pn == 5); const float sc = (pn < 2) ? C2 : 1.f;
        const int row0 = u.pm * 256 + wr * 64 + fr, col0 = pn * 256 + wc * 32 + 8 * fq;
        const int i0 = 16 * (wc & 1) + 4 * fq;
#pragma unroll
        for (int ai = 0; ai < 2; ++ai)
#pragma unroll
            for (int m = 0; m < 4; ++m) {
                const int row = row0 + ai * 128 + m * 16;
                f32x4 cs0 = (f32x4){1.f, 0.f, 1.f, 0.f}, cs1 = cs0;
                if (dorope) { const f32x4* rp = (const f32x4*)(rope + ((size_t)row * 32 + i0) * 2); cs0 = rp[0]; cs1 = rp[1]; }
#pragma unroll
                for (int bj = 0; bj < 2; ++bj) {
                    const f32x4 v0 = acc[ai][bj][m][0], v1 = acc[ai][bj][m][1];
                    float o0 = v0[0] * cs0[0] - v0[1] * cs0[1], o1 = v0[0] * cs0[1] + v0[1] * cs0[0];
                    float o2 = v0[2] * cs0[2] - v0[3] * cs0[3], o3 = v0[2] * cs0[3] + v0[3] * cs0[2];
                    float o4 = v1[0] * cs1[0] - v1[1] * cs1[1], o5 = v1[0] * cs1[1] + v1[1] * cs1[0];
                    float o6 = v1[2] * cs1[2] - v1[3] * cs1[3], o7 = v1[2] * cs1[3] + v1[3] * cs1[2];
                    v4u w; w.x = cvt_pk_bf16(o0 * sc, o1 * sc); w.y = cvt_pk_bf16(o2 * sc, o3 * sc); w.z = cvt_pk_bf16(o4 * sc, o5 * sc); w.w = cvt_pk_bf16(o6 * sc, o7 * sc);
                    *(v4u*)(O + (size_t)row * NPROJ + col0 + bj * 128) = w;
                }
            }
    }
};

__device__ __forceinline__ void glds16(const void* gsrc, unsigned lds_dst) { unsigned keep;
    asm volatile("s_mov_b32 %0, m0\n\ts_mov_b32 m0, %2\n\ts_nop 0\n\tglobal_load_lds_dwordx4 %1, off\n\ts_mov_b32 m0, %0" : "=&s"(keep) : "v"(gsrc), "s"(lds_dst) : "memory"); }
#define WAIT_BAR(N) asm volatile("s_waitcnt vmcnt(" #N ") lgkmcnt(0)\n\ts_barrier" ::: "memory")
#define LBAR() asm volatile("s_waitcnt lgkmcnt(0)\n\ts_barrier" ::: "memory")
typedef LAS const unsigned char* lds_cptr;
__device__ __forceinline__ s16x4 vtr(lds_cptr p) { return __builtin_bit_cast(s16x4, __builtin_amdgcn_ds_read_tr16_b64_v4i16((LAS v4i16_t*)p)); }
#define MFMA32(a, b, c) __builtin_amdgcn_mfma_f32_32x32x16_bf16(a, b, c, 0, 0, 0)
__device__ __forceinline__ bf16x8 cat4(s16x4 lo, s16x4 hi) { return (bf16x8){lo[0], lo[1], lo[2], lo[3], hi[0], hi[1], hi[2], hi[3]}; }

__device__ __forceinline__ void qkt(f32x16& p0, f32x16& p1, lds_cptr Kimg, const bf16x8* qr, int r32, int hi, const f32x16 cin) {
    lds_cptr kb = Kimg + r32 * 128; const int sw = (r32 >> 1) & 7;
    p0 = cin; p1 = cin;
#pragma unroll
    for (int d0 = 0; d0 < 4; ++d0) {
        const int co = ((2 * d0 + hi) ^ sw) * 16;
        const bf16x8 b0 = *(const LAS bf16x8*)(kb + co);
        const bf16x8 b1 = *(const LAS bf16x8*)(kb + 4096 + co);
        p0 = MFMA32(b0, qr[d0], p0); p1 = MFMA32(b1, qr[d0], p1);
    }
}
__device__ __forceinline__ float rowmax32(const f32x16& p0, const f32x16& p1) {
    float a = fmaxf(p0[0], p1[0]);
#pragma unroll
    for (int r = 1; r < 16; ++r) a = fmaxf(a, fmaxf(p0[r], p1[r]));
    auto rr = __builtin_amdgcn_permlane32_swap(__float_as_uint(a), __float_as_uint(a), false, false);
    return fmaxf(__uint_as_float(rr[0]), __uint_as_float(rr[1]));
}

template <int MODE>
__device__ __forceinline__ void attn_unit(LAS unsigned char* lds, bf16* PROJ, int b, int h, int j, float lam, const float* subln_g, int tid, bf16* obase, int opitch, int dir, float& nm1, float& nm2, float& sgn) {
    const int lane = tid & 63, wid = __builtin_amdgcn_readfirstlane(tid >> 6), half = wid >> 2, wq = wid & 3, r32 = lane & 31, hi = lane >> 5;
    const size_t rowbase = (size_t)b * SEQ; const int q0 = 128 * j;
    const bf16* Qw = PROJ + (rowbase + q0 + 32 * wq) * NPROJ + C_DQ + 128 * h;
    const bf16* Kh = PROJ + rowbase * NPROJ + C_DK + 128 * h;
    const bf16* Vh = PROJ + rowbase * NPROJ + C_DV + 128 * h;
    const int nsteps = j + 1, cw = 2 * j + (wq >> 1);
#define TI(s_) ((dir ? 2 * (nsteps - 1 - (s_)) : 2 * (s_)) + half)
    bf16x8 q1[4], q2[4];
#pragma unroll
    for (int d0 = 0; d0 < 4; ++d0) { q1[d0] = *(const bf16x8*)(Qw + (size_t)r32 * NPROJ + d0 * 16 + hi * 8); q2[d0] = *(const bf16x8*)(Qw + (size_t)r32 * NPROJ + 64 + d0 * 16 + hi * 8); }
    const unsigned lds0 = (unsigned)(uintptr_t)lds;
    const unsigned hb = lds0 + (unsigned)half * 65536u;
    const bf16* ksrc = Kh + (size_t)(16 * wq + (lane >> 3)) * NPROJ + (((lane & 7) ^ (lane >> 4)) * 8);
    const bf16* ksrc2 = Kh + (size_t)(16 * wq + 8 + (lane >> 3)) * NPROJ + (((lane & 7) ^ (4 + (lane >> 4))) * 8);
    const bf16* vsrc = Vh + (size_t)(lane >> 2) * NPROJ + 32 * wq + (lane & 3) * 8;
#define DMA_K(t, buf) do { const bf16* s_ = ksrc + (size_t)(t) * 64 * NPROJ; const unsigned d_ = hb + (unsigned)(buf) * 32768u + (unsigned)(2 * wq) * 1024u; \
        glds16(s_, (unsigned)__builtin_amdgcn_readfirstlane(d_)); glds16(s_ + 64, (unsigned)__builtin_amdgcn_readfirstlane(d_ + 8192u)); \
        const bf16* s2_ = ksrc2 + (size_t)(t) * 64 * NPROJ; \
        glds16(s2_, (unsigned)__builtin_amdgcn_readfirstlane(d_ + 1024u)); glds16(s2_ + 64, (unsigned)__builtin_amdgcn_readfirstlane(d_ + 8192u + 1024u)); } while (0)
#define DMA_V(t, buf) do { const bf16* s_ = vsrc + (size_t)(t) * 64 * NPROJ; const unsigned d_ = hb + (unsigned)(buf) * 32768u + 16384u + (unsigned)(wq * 4) * 1024u; \
        _Pragma("unroll") for (int rg_ = 0; rg_ < 4; ++rg_) glds16(s_ + (size_t)rg_ * 16 * NPROJ, (unsigned)__builtin_amdgcn_readfirstlane(d_ + (unsigned)rg_ * 1024u)); } while (0)
    lds_cptr hbp = (lds_cptr)lds + half * 65536;
#define ACT(s_) (TI(s_) <= cw)
#define UPD(P0, P1, M, L) do { const float rm_ = rowmax32(P0, P1), mn_ = fmaxf(M, rm_); float sacc_ = 0.f; \
        _Pragma("unroll") for (int r = 0; r < 16; ++r) sacc_ += ex2(P0[r] - mn_) + ex2(P1[r] - mn_); \
        L = L * ex2(M - mn_) + sacc_; M = mn_; } while (0)
    f32x16 sa0 = f32x16{}, sa1 = f32x16{}, sb0 = f32x16{}, sb1 = f32x16{};
    if constexpr (MODE == 1) {
    float m1 = -INFINITY, l1 = 0.f, m2 = -INFINITY, l2 = 0.f;
    DMA_K(TI(0), 0);
    for (int s = 0; s < nsteps; ++s) {
        WAIT_BAR(0);
        if (s + 1 < nsteps) DMA_K(TI(s + 1), (s + 1) & 1);
        if (half == 1 && s > 0 && ACT(s - 1)) { UPD(sa0, sa1, m1, l1); UPD(sb0, sb1, m2, l2); }
        if (ACT(s)) { lds_cptr kb = hbp + (s & 1) * 32768; qkt(sa0, sa1, kb, q1, r32, hi, f32x16{}); qkt(sb0, sb1, kb + 8192, q2, r32, hi, f32x16{}); }
        if (half == 0 && ACT(s)) { UPD(sa0, sa1, m1, l1); UPD(sb0, sb1, m2, l2); }
    }
    if (half == 1 && ACT(nsteps - 1)) { UPD(sa0, sa1, m1, l1); UPD(sb0, sb1, m2, l2); }
    { auto rr = __builtin_amdgcn_permlane32_swap(__float_as_uint(l1), __float_as_uint(l1), false, false); l1 = __uint_as_float(rr[0]) + __uint_as_float(rr[1]); }
    { auto rr = __builtin_amdgcn_permlane32_swap(__float_as_uint(l2), __float_as_uint(l2), false, false); l2 = __uint_as_float(rr[0]) + __uint_as_float(rr[1]); }
    LAS float* st = (LAS float*)(lds + 131072);
    if (hi == 0) { LAS float* p = st + ((half * 4 + wq) * 4) * 32 + r32; p[0] = m1; p[32] = l1; p[64] = m2; p[96] = l2; }
    LBAR();
    { const LAS float* pa = st + ((0 * 4 + wq) * 4) * 32 + r32; const LAS float* pb = st + ((1 * 4 + wq) * 4) * 32 + r32;
      const float ma = pa[0], la = pa[32], mb = pb[0], lb = pb[32]; const float mf1 = fmaxf(ma, mb); const float lf1 = la * ex2(ma - mf1) + lb * ex2(mb - mf1);
      const float ma2 = pa[64], la2 = pa[96], mb2 = pb[64], lb2 = pb[96]; const float mf2 = fmaxf(ma2, mb2); const float lf2 = la2 * ex2(ma2 - mf2) + lb2 * ex2(mb2 - mf2);
      nm1 = -(mf1 + __builtin_amdgcn_logf(lf1)); nm2 = -(mf2 + __builtin_amdgcn_logf(lf2) - __builtin_amdgcn_logf(fabsf(lam))); sgn = lam > 0.f ? -1.f : 1.f; }
    LBAR();
    } else {
    f32x16 o[4];
#pragma unroll
    for (int d = 0; d < 4; ++d) o[d] = f32x16{};
    const int vro = ((lane >> 4) & 1) * 32 + (lane & 3) * 8 + (4 * hi + ((lane & 15) >> 2)) * 64;
    v4u pw[4];
#define EXPPACK() do { \
        _Pragma("unroll") for (int r = 0; r < 16; ++r) { sa0[r] = ex2(sa0[r] + nm1) + sgn * ex2(sb0[r] + nm2); sa1[r] = ex2(sa1[r] + nm1) + sgn * ex2(sb1[r] + nm2); } \
        pw[0] = (v4u){cvt_pk_bf16(sa0[0], sa0[1]), cvt_pk_bf16(sa0[2], sa0[3]), cvt_pk_bf16(sa0[4], sa0[5]), cvt_pk_bf16(sa0[6], sa0[7])}; \
        pw[1] = (v4u){cvt_pk_bf16(sa0[8], sa0[9]), cvt_pk_bf16(sa0[10], sa0[11]), cvt_pk_bf16(sa0[12], sa0[13]), cvt_pk_bf16(sa0[14], sa0[15])}; \
        pw[2] = (v4u){cvt_pk_bf16(sa1[0], sa1[1]), cvt_pk_bf16(sa1[2], sa1[3]), cvt_pk_bf16(sa1[4], sa1[5]), cvt_pk_bf16(sa1[6], sa1[7])}; \
        pw[3] = (v4u){cvt_pk_bf16(sa1[8], sa1[9]), cvt_pk_bf16(sa1[10], sa1[11]), cvt_pk_bf16(sa1[12], sa1[13]), cvt_pk_bf16(sa1[14], sa1[15])}; } while (0)
#define PVSTEP(slot_) do { \
        lds_cptr vp = hbp + (slot_) * 32768 + 16384 + vro; \
        _Pragma("unroll") for (int d = 0; d < 4; ++d) { \
            _Pragma("unroll") for (int ks = 0; ks < 4; ++ks) { \
                const s16x4 lo = vtr(vp + d * 4096 + ks * 1024), hh = vtr(vp + d * 4096 + ks * 1024 + 512); \
                o[d] = MFMA32(__builtin_bit_cast(bf16x8, pw[ks]), cat4(lo, hh), o[d]); } \
            __builtin_amdgcn_sched_barrier(0); } } while (0)
    DMA_K(TI(0), 0); if (half == 0) DMA_V(TI(0), 0);
    for (int s = 0; s < nsteps; ++s) {
        WAIT_BAR(0);
        if (s + 1 < nsteps) DMA_K(TI(s + 1), (s + 1) & 1);
        if (half == 0) { if (s + 1 < nsteps) DMA_V(TI(s + 1), (s + 1) & 1); } else { DMA_V(TI(s), s & 1); }
        if (half == 1 && s > 0 && ACT(s - 1)) PVSTEP((s - 1) & 1);
        if (ACT(s)) { lds_cptr kb = hbp + (s & 1) * 32768; qkt(sa0, sa1, kb, q1, r32, hi, f32x16{}); qkt(sb0, sb1, kb + 8192, q2, r32, hi, f32x16{}); EXPPACK(); }
        if (half == 0 && ACT(s)) PVSTEP(s & 1);
    }
    WAIT_BAR(0);
    if (half == 1 && ACT(nsteps - 1)) PVSTEP((nsteps - 1) & 1);
    LBAR();
#undef EXPPACK
#undef ACT
#undef UPD
#undef PVSTEP
    LAS float* ox = (LAS float*)lds;
    if (half == 1) {
#pragma unroll
        for (int d = 0; d < 4; ++d)
#pragma unroll
            for (int r = 0; r < 16; ++r) ox[((wq * 4 + d) * 16 + r) * 64 + lane] = o[d][r];
    }
    LBAR();
    LAS float* ot = (LAS float*)(lds + 65536);
    if (half == 0) {
#pragma unroll
        for (int d = 0; d < 4; ++d)
#pragma unroll
            for (int r = 0; r < 16; ++r) { const float v = o[d][r] + ox[((wq * 4 + d) * 16 + r) * 64 + lane]; ot[(wq * 32 + crow(r, hi)) * 132 + 32 * d + r32] = v; }
        LDS_WAIT();
        const int q = lane >> 1, c0 = 64 * (lane & 1);
        const LAS f32x4* src = (const LAS f32x4*)(ot + (wq * 32 + q) * 132 + c0);
        f32x4 v[16]; float ss = 0.f;
#pragma unroll
        for (int i = 0; i < 16; ++i) { v[i] = src[i]; ss += (v[i].x * v[i].x + v[i].y * v[i].y) + (v[i].z * v[i].z + v[i].w * v[i].w); }
        ss += __shfl_xor(ss, 1);
        const float rs = (1.f - LAM_INIT) / sqrtf(ss * (1.f / 128.f) + LN_EPS);
        bf16* dst = obase + (rowbase + q0 + 32 * wq + q) * opitch + 128 * h + c0;
#pragma unroll
        for (int i = 0; i < 8; ++i) {
            const f32x4 ga = *(const f32x4*)(subln_g + c0 + 8 * i), gb = *(const f32x4*)(subln_g + c0 + 8 * i + 4);
            const f32x4 x0 = v[2 * i] * rs * ga, x1 = v[2 * i + 1] * rs * gb;
            v4u w; w.x = cvt_pk_bf16(x0.x, x0.y); w.y = cvt_pk_bf16(x0.z, x0.w); w.z = cvt_pk_bf16(x1.x, x1.y); w.w = cvt_pk_bf16(x1.z, x1.w);
            *(v4u*)(dst + 8 * i) = w;
        }
    }
    LBAR();
    }
#undef TI
#undef DMA_K
#undef DMA_V
}

__device__ __forceinline__ int tr_nat_off(int lane) { return ((lane >> 4) & 1) * 32 + (lane & 3) * 8 + (8 * (lane >> 5) + ((lane & 15) >> 2)) * 64; }
constexpr size_t BC_OFF_FLOATS = 8u * 1024u * 1024u;

__device__ __forceinline__ void gla_a_wave(const Args& a, LAS unsigned char* wl, int unit, int eh, int lane) {
    const int bh = unit >> 5, n = unit & 31, b = bh >> 2, h = bh & 3, hi = lane >> 5, r32 = lane & 31;
    const size_t row0 = (size_t)b * SEQ + n * 64;
    const bf16* PROJ = (const bf16*)(a.ws + WS_A);
    const unsigned wl0 = (unsigned)(uintptr_t)wl;
#pragma unroll
    for (int p = 0; p < 8; ++p) { const int dblk = 2 * eh + (p >> 2), rg = p & 3;
        glds16(PROJ + (row0 + 16 * rg + (lane >> 2)) * NPROJ + C_GV + 128 * h + 32 * dblk + (lane & 3) * 8, (unsigned)__builtin_amdgcn_readfirstlane(wl0 + p * 1024));
        glds16(PROJ + (row0 + 16 * rg + (lane >> 2)) * NPROJ + C_GK + 64 * h + 32 * (p >> 2) + (lane & 3) * 8, (unsigned)__builtin_amdgcn_readfirstlane(wl0 + 8192 + p * 1024)); }
    bf16x8 ga[2], wb[2];
#pragma unroll
    for (int tb = 0; tb < 2; ++tb) { const f32x4* gp = (const f32x4*)((const float*)(a.ws + WS_GLOW) + (row0 + 32 * tb + r32) * 16 + 8 * hi); const f32x4 x0 = gp[0], x1 = gp[1];
        ga[tb] = __builtin_bit_cast(bf16x8, (v4u){cvt_pk_bf16(x0.x, x0.y), cvt_pk_bf16(x0.z, x0.w), cvt_pk_bf16(x1.x, x1.y), cvt_pk_bf16(x1.z, x1.w)}); }
#pragma unroll
    for (int db = 0; db < 2; ++db) { const float* wp = a.wg2 + (8 * hi) * 256 + 64 * h + 32 * db + r32;
        wb[db] = __builtin_bit_cast(bf16x8, (v4u){cvt_pk_bf16(wp[0], wp[256]), cvt_pk_bf16(wp[512], wp[768]), cvt_pk_bf16(wp[1024], wp[1280]), cvt_pk_bf16(wp[1536], wp[1792])}); }
    float* BC = a.out + BC_OFF_FLOATS + (size_t)unit * 4096;
#pragma unroll
    for (int db = 0; db < 2; ++db) {
        const int d = 32 * db + r32; const float b2 = a.bg2[64 * h + d];
        f32x16 z[2];
#pragma unroll
        for (int tb = 0; tb < 2; ++tb) z[tb] = MFMA32(ga[tb], wb[db], f32x16{});
        float T[2][4], Tp[2][4];
#pragma unroll
        for (int tb = 0; tb < 2; ++tb)
#pragma unroll
            for (int g = 0; g < 4; ++g) { float run = 0.f;
#pragma unroll
                for (int i = 0; i < 4; ++i) { const float zz = z[tb][4 * g + i] + b2; run += (fminf(zz, 0.f) - __logf(1.f + __expf(-fabsf(zz)))) * (1.f / 16.f); z[tb][4 * g + i] = run; }
                T[tb][g] = run; Tp[tb][g] = __shfl_xor(run, 32); }
        float base = 0.f;
        LAS bf16* kimg = (LAS bf16*)(wl + 8192) + db * 2048 + r32;
        if (db == 0) asm volatile("s_waitcnt vmcnt(0)" ::: "memory");
#pragma unroll
        for (int tb = 0; tb < 2; ++tb)
#pragma unroll
            for (int g = 0; g < 4; ++g) { const float mine = base + (hi ? Tp[tb][g] : 0.f);
#pragma unroll
                for (int i = 0; i < 4; ++i) { const int r = 4 * g + i, t = 32 * tb + crow(r, hi); const float bc = mine + z[tb][r];
                    if (eh == 0) BC[t * 64 + d] = bc;
                    LAS bf16* kq = kimg + (2 * tb + (r >> 3)) * 512 + (((r & 3) + 8 * ((r >> 2) & 1)) + 4 * hi) * 32;
                    *kq = (bf16)(cvt_pk_bf16(bf_lo((unsigned)*kq) * __expf(-bc), 0.f) & 0xffffu); }
                base += T[tb][g] + Tp[tb][g]; }
        if (eh == 0 && hi == 0) ((float*)(a.ws + WS_DEC))[(size_t)unit * 64 + d] = __expf(base);
    }
    asm volatile("s_waitcnt vmcnt(0) lgkmcnt(0)" ::: "memory");
    const int tro = tr_nat_off(lane);
    bf16x8 af[2][4];
#pragma unroll
    for (int db = 0; db < 2; ++db)
#pragma unroll
        for (int sk = 0; sk < 4; ++sk) { lds_cptr p = (lds_cptr)wl + 8192 + db * 4096 + sk * 1024 + tro; af[db][sk] = cat4(vtr(p), vtr(p + 256)); }
    bf16* DS = (bf16*)(a.ws + WS_DS) + (size_t)unit * 8192;
#pragma unroll
    for (int ebl = 0; ebl < 2; ++ebl) {
        f32x16 acc0 = f32x16{}, acc1 = f32x16{};
#pragma unroll
        for (int sk = 0; sk < 4; ++sk) { lds_cptr p = (lds_cptr)wl + ebl * 4096 + sk * 1024 + tro; const bf16x8 bfr = cat4(vtr(p), vtr(p + 256));
            acc0 = MFMA32(af[0][sk], bfr, acc0); acc1 = MFMA32(af[1][sk], bfr, acc1); }
        const int e = 32 * (2 * eh + ebl) + r32;
#pragma unroll
        for (int r = 0; r < 16; r += 2) { const unsigned p0 = cvt_pk_bf16(acc0[r], acc0[r + 1]), p1 = cvt_pk_bf16(acc1[r], acc1[r + 1]);
            DS[crow(r, hi) * 128 + e] = (bf16)(p0 & 0xffffu); DS[crow(r + 1, hi) * 128 + e] = (bf16)(p0 >> 16);
            DS[(32 + crow(r, hi)) * 128 + e] = (bf16)(p1 & 0xffffu); DS[(32 + crow(r + 1, hi)) * 128 + e] = (bf16)(p1 >> 16); }
    }
    asm volatile("s_waitcnt lgkmcnt(0)" ::: "memory");
}

__device__ __forceinline__ void gla_c_wave(const Args& a, LAS unsigned char* ul, int unit, int cb, bool valid, int lane, bool dry) {
    const int r32 = lane & 31, hi = lane >> 5;
    const int bh = unit >> 5, n = unit & 31, b = bh >> 2, h = bh & 3;
    const size_t row0 = (size_t)b * SEQ + n * 64;
    bf16* PROJ = (bf16*)(a.ws + WS_A);
    const int c = 32 * cb + r32;
    bf16x8 qf[4], kf[2][4];
#pragma unroll
    for (int d0 = 0; d0 < 4; ++d0) { qf[d0] = bf16x8{}; kf[0][d0] = bf16x8{}; kf[1][d0] = bf16x8{}; }
    if (valid) {
        const unsigned ul0 = (unsigned)(uintptr_t)ul;
        const bf16* SP = (const bf16*)(a.ws + WS_SP) + (size_t)unit * 8192;
#pragma unroll
        for (int p = 0; p < 8; ++p) { const int pp = 8 * cb + p, dblk = pp >> 2, rg = pp & 3;
            glds16(PROJ + (row0 + 16 * rg + (lane >> 2)) * NPROJ + C_GV + 128 * h + 32 * dblk + (lane & 3) * 8, (unsigned)__builtin_amdgcn_readfirstlane(ul0 + pp * 1024));
            glds16(SP + (16 * rg + (lane >> 2)) * 128 + 32 * dblk + (lane & 3) * 8, (unsigned)__builtin_amdgcn_readfirstlane(ul0 + 16384 + pp * 1024)); }
        const float* BC = a.out + BC_OFF_FLOATS + (size_t)unit * 4096;
#pragma unroll
        for (int d0 = 0; d0 < 4; ++d0) {
            { const v4u qq = *(const v4u*)(PROJ + (row0 + c) * NPROJ + C_GQ + 64 * h + 16 * d0 + 8 * hi);
              const f32x4 c0 = *(const f32x4*)(BC + c * 64 + 16 * d0 + 8 * hi), c1 = *(const f32x4*)(BC + c * 64 + 16 * d0 + 8 * hi + 4); v4u w;
              w.x = cvt_pk_bf16(bf_lo(qq.x) * 0.125f * __expf(c0.x), bf_hi(qq.x) * 0.125f * __expf(c0.y));
              w.y = cvt_pk_bf16(bf_lo(qq.y) * 0.125f * __expf(c0.z), bf_hi(qq.y) * 0.125f * __expf(c0.w));
              w.z = cvt_pk_bf16(bf_lo(qq.z) * 0.125f * __expf(c1.x), bf_hi(qq.z) * 0.125f * __expf(c1.y));
              w.w = cvt_pk_bf16(bf_lo(qq.w) * 0.125f * __expf(c1.z), bf_hi(qq.w) * 0.125f * __expf(c1.w));
              qf[d0] = __builtin_bit_cast(bf16x8, w); }
#pragma unroll
            for (int jb = 0; jb < 2; ++jb) if (jb <= cb) { const int jr = 32 * jb + r32;
                const v4u kk = *(const v4u*)(PROJ + (row0 + jr) * NPROJ + C_GK + 64 * h + 16 * d0 + 8 * hi);
                const f32x4 c0 = *(const f32x4*)(BC + jr * 64 + 16 * d0 + 8 * hi), c1 = *(const f32x4*)(BC + jr * 64 + 16 * d0 + 8 * hi + 4); v4u w;
                w.x = cvt_pk_bf16(bf_lo(kk.x) * __expf(-c0.x), bf_hi(kk.x) * __expf(-c0.y));
                w.y = cvt_pk_bf16(bf_lo(kk.y) * __expf(-c0.z), bf_hi(kk.y) * __expf(-c0.w));
                w.z = cvt_pk_bf16(bf_lo(kk.z) * __expf(-c1.x), bf_hi(kk.z) * __expf(-c1.y));
                w.w = cvt_pk_bf16(bf_lo(kk.w) * __expf(-c1.z), bf_hi(kk.w) * __expf(-c1.w));
                kf[jb][d0] = __builtin_bit_cast(bf16x8, w); }
        }
    }
    WAIT_BAR(0);
    f32x16 o[4];
#pragma unroll
    for (int eb = 0; eb < 4; ++eb) o[eb] = f32x16{};
    if (valid) {
        const int vro = ((lane >> 4) & 1) * 32 + (lane & 3) * 8 + (4 * hi + ((lane & 15) >> 2)) * 64;
#pragma unroll
        for (int jb = 0; jb < 2; ++jb) if (jb <= cb) {
            f32x16 X = f32x16{};
#pragma unroll
            for (int d0 = 0; d0 < 4; ++d0) X = MFMA32(kf[jb][d0], qf[d0], X);
            if (jb == cb) {
#pragma unroll
                for (int r = 0; r < 16; ++r) if (crow(r, hi) > r32) X[r] = 0.f;
            }
            const v4u pw0 = (v4u){cvt_pk_bf16(X[0], X[1]), cvt_pk_bf16(X[2], X[3]), cvt_pk_bf16(X[4], X[5]), cvt_pk_bf16(X[6], X[7])};
            const v4u pw1 = (v4u){cvt_pk_bf16(X[8], X[9]), cvt_pk_bf16(X[10], X[11]), cvt_pk_bf16(X[12], X[13]), cvt_pk_bf16(X[14], X[15])};
#pragma unroll
            for (int eb = 0; eb < 4; ++eb) { lds_cptr vp = (lds_cptr)ul + eb * 4096 + vro;
                o[eb] = MFMA32(__builtin_bit_cast(bf16x8, pw0), cat4(vtr(vp + (2 * jb) * 1024), vtr(vp + (2 * jb) * 1024 + 512)), o[eb]);
                o[eb] = MFMA32(__builtin_bit_cast(bf16x8, pw1), cat4(vtr(vp + (2 * jb + 1) * 1024), vtr(vp + (2 * jb + 1) * 1024 + 512)), o[eb]); }
        }
        const int tro = tr_nat_off(lane);
#pragma unroll
        for (int eb = 0; eb < 4; ++eb)
#pragma unroll
            for (int d0 = 0; d0 < 4; ++d0) { lds_cptr sp = (lds_cptr)ul + 16384 + eb * 4096 + d0 * 1024 + tro; o[eb] = MFMA32(qf[d0], cat4(vtr(sp), vtr(sp + 256)), o[eb]); }
    }
    LBAR();
    if (valid) {
        LAS float* os = (LAS float*)(ul + cb * 16384);
#pragma unroll
        for (int eb = 0; eb < 4; ++eb)
#pragma unroll
            for (int r = 0; r < 16; ++r) { const int rr = crow(r, hi), e = 32 * eb + r32; os[rr * 128 + (((e >> 2) + rr) & 31) * 4 + (e & 3)] = o[eb][r]; }
        asm volatile("s_waitcnt lgkmcnt(0)" ::: "memory");
        const int rr = lane >> 1, hf = lane & 1;
        f32x4 v[16]; float ss = 0.f;
#pragma unroll
        for (int i = 0; i < 16; ++i) { v[i] = *(const LAS f32x4*)(os + rr * 128 + ((16 * hf + i + rr) & 31) * 4); ss += (v[i].x * v[i].x + v[i].y * v[i].y) + (v[i].z * v[i].z + v[i].w * v[i].w); }
        ss += __shfl_xor(ss, 1);
        const float rs = 1.f / sqrtf(ss * (1.f / 128.f) + LN_EPS);
        bf16* gp = PROJ + (row0 + 32 * cb + rr) * NPROJ + C_GO + 128 * h + 64 * hf;
        bf16* op = dry ? (bf16*)a.out + (row0 + 32 * cb + rr) * 512 + 128 * h + 64 * hf : gp;
#pragma unroll
        for (int i = 0; i < 8; ++i) {
            const v4u gg = *(const v4u*)(gp + 8 * i);
            const f32x4 gn0 = *(const f32x4*)(a.gla_norm_g + 64 * hf + 8 * i), gn1 = *(const f32x4*)(a.gla_norm_g + 64 * hf + 8 * i + 4);
            const float g0 = bf_lo(gg.x), g1 = bf_hi(gg.x), g2 = bf_lo(gg.y), g3 = bf_hi(gg.y), g4 = bf_lo(gg.z), g5 = bf_hi(gg.z), g6 = bf_lo(gg.w), g7 = bf_hi(gg.w);
            const f32x4 x0 = v[2 * i] * rs * gn0, x1 = v[2 * i + 1] * rs * gn1;
            v4u w;
            w.x = cvt_pk_bf16(x0.x * g0 * __builtin_amdgcn_rcpf(1.f + __expf(-g0)), x0.y * g1 * __builtin_amdgcn_rcpf(1.f + __expf(-g1)));
            w.y = cvt_pk_bf16(x0.z * g2 * __builtin_amdgcn_rcpf(1.f + __expf(-g2)), x0.w * g3 * __builtin_amdgcn_rcpf(1.f + __expf(-g3)));
            w.z = cvt_pk_bf16(x1.x * g4 * __builtin_amdgcn_rcpf(1.f + __expf(-g4)), x1.y * g5 * __builtin_amdgcn_rcpf(1.f + __expf(-g5)));
            w.w = cvt_pk_bf16(x1.z * g6 * __builtin_amdgcn_rcpf(1.f + __expf(-g6)), x1.w * g7 * __builtin_amdgcn_rcpf(1.f + __expf(-g7)));
            *(v4u*)(op + 8 * i) = w;
        }
    }
    LBAR();
}

struct EpiPre1 {
    static constexpr bool PERM = false;
    float* out; const float* x; const float* stats; const float* g; const float* bta;
    __device__ __forceinline__ void operator()(const f32x4 (&acc)[2][2][4][2], const pg8::Unit& u, int wr, int wc, int fr, int fq) const {
        const int row0 = u.pm * 256 + wr * 64 + fr, col0 = u.pn * 256 + wc * 32 + 4 * fq;
        f32x4 gv[2][2], bv[2][2];
#pragma unroll
        for (int bj = 0; bj < 2; ++bj)
#pragma unroll
            for (int n = 0; n < 2; ++n) { gv[bj][n] = *(const f32x4*)(g + col0 + bj * 128 + n * 16); bv[bj][n] = *(const f32x4*)(bta + col0 + bj * 128 + n * 16); }
#pragma unroll
        for (int ai = 0; ai < 2; ++ai)
#pragma unroll
            for (int m = 0; m < 4; ++m) {
                const int row = row0 + ai * 128 + m * 16; const f32x2 st = *(const f32x2*)(stats + 2 * (size_t)row); const size_t off = (size_t)row * D + col0;
#pragma unroll
                for (int bj = 0; bj < 2; ++bj)
#pragma unroll
                    for (int n = 0; n < 2; ++n) { const f32x4 xv = *(const f32x4*)(x + off + bj * 128 + n * 16);
                        const f32x4 xn = (xv - st.x) * st.y * gv[bj][n] + bv[bj][n];
                        *(f32x4*)(out + off + bj * 128 + n * 16) = acc[ai][bj][m][n] + ALPHA * xn; }
            }
    }
};

struct MoeOrder {
    const int* cntl; const int* tst;
    const char* A; const char* B; const int* ltok; int lda, K, G, c; bool gather; size_t bstride_e;
    __device__ __forceinline__ bool next(int i, pg8::Unit& u) const {
        const volatile LAS int* cn = (const volatile LAS int*)cntl; const volatile LAS int* ts = (const volatile LAS int*)tst;
        const int ntot = ts[32], nun = 4 * ntot; int L;
        if ((G & 7) == 0) { const int chunk = (nun + 7) >> 3, cpx = G >> 3, xcd = c & 7, loc = c >> 3; const int o = i * cpx + loc; if (o >= chunk) return false; L = xcd * chunk + o; }
        else L = i * G + c;
        if (L >= nun) return false;
        const int tt = L >> 2, pn = L & 3; int e = 0;
        for (int k = 1; k < 32; ++k) e += (ts[k] <= tt) ? 1 : 0;
        u.pm = tt; u.pn = pn; u.e = e; u.r0 = (tt - ts[e]) * 256; u.cnt = cn[e];
        u.B = B + (size_t)e * bstride_e + (size_t)pn * 256 * K * 2;
        const int tid = threadIdx.x; int R0, C0, R1, C1; pg8::stage_rc(tid * 16, R0, C0); pg8::stage_rc(tid * 16 + 8192, R1, C1);
        if (gather) {
            u.A = A;
            const int s00 = u.r0 + R0, s01 = u.r0 + R1, s10 = u.r0 + 128 + R0, s11 = u.r0 + 128 + R1;
            const int t00 = s00 < u.cnt ? (ltok[e * LCAP + s00] >> 1) : 0, t01 = s01 < u.cnt ? (ltok[e * LCAP + s01] >> 1) : 0;
            const int t10 = s10 < u.cnt ? (ltok[e * LCAP + s10] >> 1) : 0, t11 = s11 < u.cnt ? (ltok[e * LCAP + s11] >> 1) : 0;
            u.va00 = (unsigned)(t00 * lda + C0) * 2u; u.va01 = (unsigned)(t01 * lda + C1) * 2u; u.va10 = (unsigned)(t10 * lda + C0) * 2u; u.va11 = (unsigned)(t11 * lda + C1) * 2u;
        } else {
            u.A = A + (size_t)tt * 256 * lda * 2;
            u.va00 = (unsigned)(R0 * lda + C0) * 2u; u.va01 = (unsigned)(R1 * lda + C1) * 2u; u.va10 = (unsigned)((128 + R0) * lda + C0) * 2u; u.va11 = (unsigned)((128 + R1) * lda + C1) * 2u;
        }
        return true;
    }
};
struct EpiGU {
    static constexpr bool PERM = true;
    bf16* H;
    __device__ __forceinline__ void operator()(const f32x4 (&acc)[2][2][4][2], const pg8::Unit& u, int wr, int wc, int fr, int fq) const {
        const int row0 = u.pm * 256 + wr * 64 + fr, col0 = u.pn * 128 + wc * 32 + 8 * fq;
#pragma unroll
        for (int ai = 0; ai < 2; ++ai)
#pragma unroll
            for (int m = 0; m < 4; ++m) {
                float hv[8];
#pragma unroll
                for (int n = 0; n < 2; ++n)
#pragma unroll
                    for (int i = 0; i < 4; ++i) { const float g = acc[ai][0][m][n][i], up = acc[ai][1][m][n][i]; hv[4 * n + i] = g / (1.f + __expf(-g)) * up; }
                v4u w; w.x = cvt_pk_bf16(hv[0], hv[1]); w.y = cvt_pk_bf16(hv[2], hv[3]); w.z = cvt_pk_bf16(hv[4], hv[5]); w.w = cvt_pk_bf16(hv[6], hv[7]);
                *(v4u*)(H + (size_t)(row0 + ai * 128 + m * 16) * DE + col0) = w;
            }
    }
};
struct EpiDown {
    static constexpr bool PERM = true;
    bf16* Y; const int* ltok; const float* lw;
    __device__ __forceinline__ void operator()(const f32x4 (&acc)[2][2][4][2], const pg8::Unit& u, int wr, int wc, int fr, int fq) const {
        const int col0 = u.pn * 256 + wc * 32 + 8 * fq;
#pragma unroll
        for (int ai = 0; ai < 2; ++ai)
#pragma unroll
            for (int m = 0; m < 4; ++m) {
                const int slot = u.r0 + ai * 128 + wr * 64 + m * 16 + fr;
                if (slot < u.cnt) {
                    const int ent = ltok[u.e * LCAP + slot]; const float w = lw[u.e * LCAP + slot];
                    bf16* dst = Y + ((size_t)(ent >> 1) * 2 + (ent & 1)) * D + col0;
#pragma unroll
                    for (int bj = 0; bj < 2; ++bj) { const f32x4 v0 = acc[ai][bj][m][0] * w, v1 = acc[ai][bj][m][1] * w;
                        v4u o; o.x = cvt_pk_bf16(v0[0], v0[1]); o.y = cvt_pk_bf16(v0[2], v0[3]); o.z = cvt_pk_bf16(v1[0], v1[1]); o.w = cvt_pk_bf16(v1[2], v1[3]);
                        *(v4u*)(dst + bj * 128) = o; }
                }
            }
    }
};

constexpr int P6_TP = 2064;
constexpr int P6_HI = 0, P6_LO = 16 * P6_TP, P6_RED = 2 * 16 * P6_TP, P6_LG = P6_RED + 8 * 3 * 4 * 64 * 4, P6_SE = P6_LG + 16 * 48 * 4;
__device__ __forceinline__ void phase6(const Args& a, LAS unsigned char* lds, int G, int tid, int lane, int wave, bool dry) {
    unsigned char* ws = a.ws;
    const float* pre = a.out; bf16* HB = (bf16*)(ws + WS_HB);
    int* ltok = (int*)(ws + WS_LTOK); float* lw = (float*)(ws + WS_LW); unsigned* cntg = (unsigned*)(ws + WS_CTL) + CW_CNT;
    LAS int* s_e = (LAS int*)(lds + P6_SE);
    LAS float* s_w = (LAS float*)(lds + P6_SE + 512);
    LAS int* s_rank = (LAS int*)(lds + P6_SE + 1024);
    LAS unsigned* s_cnt = (LAS unsigned*)(lds + P6_SE + 1536);
    LAS unsigned* s_base = (LAS unsigned*)(lds + P6_SE + 1664);
    LAS float* s_lg = (LAS float*)(lds + P6_LG);
    LAS float* red = (LAS float*)(lds + P6_RED);
    const bf16* WRT = (const bf16*)(ws + WS_WRT);
    bf16x8 wh[3][4], wl[3][4];
#pragma unroll
    for (int ct = 0; ct < 3; ++ct)
#pragma unroll
        for (int sk = 0; sk < 4; ++sk) { const size_t off = (size_t)(16 * ct + (lane & 15)) * 1024 + 128 * wave + 32 * sk + 8 * (lane >> 4);
            wh[ct][sk] = *(const bf16x8*)(WRT + off); wl[ct][sk] = *(const bf16x8*)(WRT + 48 * 1024 + off); }
    for (int rb = blockIdx.x; rb < T / 64; rb += G) {
        if (tid < 32) s_cnt[tid] = 0u;
        for (int grp = 0; grp < 4; ++grp) {
#pragma unroll
            for (int q = 0; q < 2; ++q) {
                const int rl = 2 * wave + q; const size_t m = (size_t)rb * 64 + grp * 16 + rl;
                const GAS f32x4* xr = (const GAS f32x4*)(pre + m * D) + lane;
                f32x4 v[4]; float s = 0.f;
#pragma unroll
                for (int j = 0; j < 4; ++j) { v[j] = xr[64 * j]; s += (v[j].x + v[j].y) + (v[j].z + v[j].w); }
                const float mean = wave_sum(s) * (1.f / D); float s2 = 0.f;
#pragma unroll
                for (int j = 0; j < 4; ++j) { v[j] = v[j] - mean; s2 += (v[j].x * v[j].x + v[j].y * v[j].y) + (v[j].z * v[j].z + v[j].w * v[j].w); }
                const float rstd = 1.f / sqrtf(wave_sum(s2) * (1.f / D) + LN_EPS);
                GAS v2u* o8 = (GAS v2u*)(HB + m * D) + lane;
#pragma unroll
                for (int j = 0; j < 4; ++j) {
                    v[j] = v[j] * rstd * *(const f32x4*)(a.ln1_g + 4 * lane + 256 * j) + *(const f32x4*)(a.ln1_b + 4 * lane + 256 * j);
                    v2u hw; hw.x = cvt_pk_bf16(v[j].x, v[j].y); hw.y = cvt_pk_bf16(v[j].z, v[j].w); o8[64 * j] = hw;
                    v2u lw2; lw2.x = cvt_pk_bf16(v[j].x - bf_lo(hw.x), v[j].y - bf_hi(hw.x)); lw2.y = cvt_pk_bf16(v[j].z - bf_lo(hw.y), v[j].w - bf_hi(hw.y));
                    *(LAS v2u*)(lds + P6_HI + rl * P6_TP + (4 * lane + 256 * j) * 2) = hw;
                    *(LAS v2u*)(lds + P6_LO + rl * P6_TP + (4 * lane + 256 * j) * 2) = lw2;
                }
            }
            __syncthreads();
            {
                f32x4 acc[3];
#pragma unroll
                for (int ct = 0; ct < 3; ++ct) acc[ct] = (f32x4){0.f, 0.f, 0.f, 0.f};
#pragma unroll
                for (int sk = 0; sk < 4; ++sk) {
                    const int boff = (lane & 15) * P6_TP + (128 * wave + 32 * sk + 8 * (lane >> 4)) * 2;
                    const bf16x8 ah = *(const LAS bf16x8*)(lds + P6_HI + boff), al = *(const LAS bf16x8*)(lds + P6_LO + boff);
#pragma unroll
                    for (int ct = 0; ct < 3; ++ct) {
                        acc[ct] = __builtin_amdgcn_mfma_f32_16x16x32_bf16(ah, wh[ct][sk], acc[ct], 0, 0, 0);
                        acc[ct] = __builtin_amdgcn_mfma_f32_16x16x32_bf16(al, wh[ct][sk], acc[ct], 0, 0, 0);
                        acc[ct] = __builtin_amdgcn_mfma_f32_16x16x32_bf16(ah, wl[ct][sk], acc[ct], 0, 0, 0);
                    }
                }
#pragma unroll
                for (int ct = 0; ct < 3; ++ct)
#pragma unroll
                    for (int r = 0; r < 4; ++r) red[((wave * 3 + ct) * 4 + r) * 64 + lane] = acc[ct][r];
            }
            __syncthreads();
            for (int o = tid; o < 16 * 48; o += 512) {
                const int row = o / 48, col = o % 48, ct = col >> 4, ls = (col & 15) + 16 * (row >> 2), r = row & 3; float sum = 0.f;
#pragma unroll
                for (int w = 0; w < 8; ++w) sum += red[((w * 3 + ct) * 4 + r) * 64 + ls];
                s_lg[row * 48 + col] = sum;
            }
            __syncthreads();
            if (tid < 16) {
                const LAS float* lgp = s_lg + tid * 48;
                float gq[4];
#pragma unroll
                for (int k = 0; k < 4; ++k) gq[k] = lgp[k] + a.b_rg[k];
                int gt = 0; float gm = gq[0];
#pragma unroll
                for (int k = 1; k < 4; ++k) if (gq[k] > gm) { gm = gq[k]; gt = k; }
                float den = 0.f;
#pragma unroll
                for (int k = 0; k < 4; ++k) den += __expf(gq[k] - gm);
                const float pg = 1.f / den;
                float ev[8];
#pragma unroll
                for (int k = 0; k < 8; ++k) ev[k] = lgp[4 + 8 * gt + k] + a.b_re[8 * gt + k];
                int i0 = 0; float v0 = ev[0];
#pragma unroll
                for (int k = 1; k < 8; ++k) if (ev[k] > v0) { v0 = ev[k]; i0 = k; }
                int i1 = 0; float v1 = -INFINITY;
#pragma unroll
                for (int k = 0; k < 8; ++k) if (k != i0 && ev[k] > v1) { v1 = ev[k]; i1 = k; }
                const float t = __expf(v1 - v0), w0 = pg / (1.f + t), w1 = pg * t / (1.f + t);
                const int aidx = (grp * 16 + tid) * 2; s_e[aidx] = 8 * gt + i0; s_w[aidx] = w0; s_e[aidx + 1] = 8 * gt + i1; s_w[aidx + 1] = w1;
            }
        }
        __syncthreads();
        if (dry) continue;
        if (tid < 128) s_rank[tid] = (int)atomicAdd((unsigned*)&s_cnt[s_e[tid]], 1u);
        __syncthreads();
        if (tid < 32) s_base[tid] = s_cnt[tid] ? __hip_atomic_fetch_add(cntg + tid, s_cnt[tid], RLX_AGENT) : 0u;
        __syncthreads();
        if (tid < 128) { const int e = s_e[tid]; const unsigned slot = s_base[e] + (unsigned)s_rank[tid]; const int tok = rb * 64 + (tid >> 1);
            ltok[e * LCAP + slot] = (tok << 1) | (tid & 1); lw[e * LCAP + slot] = s_w[tid]; }
        __syncthreads();
    }
}

constexpr int NPH = 10;
__global__ void __launch_bounds__(512, 2) fwd_kernel(Args a) {
    extern __shared__ __attribute__((aligned(16))) unsigned char lds_raw[];
    LAS unsigned char* lds = (LAS unsigned char*)lds_raw;
    const int tid = threadIdx.x, lane = tid & 63, wave = __builtin_amdgcn_readfirstlane(tid >> 6);
    const int G = gridDim.x; const int bx = blockIdx.x; const int vcu = (G % 8 == 0) ? (bx % 8) * (G / 8) + bx / 8 : bx;
    unsigned char* ws = a.ws;
    unsigned* ctl = (unsigned*)(ws + WS_CTL);
    volatile LAS unsigned* MISC = (volatile LAS unsigned*)(lds + LDSCTL_OFF);
    for (int u = tid; u < 256; u += 512) ((LAS unsigned*)(lds + LDSCTL_OFF))[u] = 0u;
    __syncthreads();
    XcdBarrier bar; bar.bar = ctl + CW_BAR; bar.x = 0; bar.st = nullptr;
    if (!MK_SPLIT) bar = xcd_barrier_post(ctl + CW_BAR, MISC + 8);
    const int lo = a.ph_lo, hi_ph = a.ph_hi;
#ifndef PH_MASK
#define PH_MASK 0x3ff
#endif
#define IN(k) (((PH_MASK >> (k)) & 1) && lo <= (k) && (k) < hi_ph)
#ifndef REP_MASK
#define REP_MASK 0
#endif
#define REPS(k) _Pragma("unroll") for (int rep_ = 0; rep_ <= ((REP_MASK >> (k)) & 1); ++rep_)
#define SEAM(k) do { if (IN(k) && IN((k) + 1)) xcd_barrier(bar); } while (0)
    bf16* PROJ = (bf16*)(ws + WS_A);

    if (IN(0)) REPS(0) { phase0<1 + ((REP_MASK >> 10) & 1), 1 + ((REP_MASK >> 11) & 1), 1 + ((REP_MASK >> 12) & 1)>(a, lds, vcu, G, tid, lane, wave); __syncthreads(); }
    SEAM(0);
    if (IN(1)) REPS(1) {
        pg8::DenseOrder S; S.init(ws + WS_B, 1024, ws + WS_WIN, 1024, T, NPROJ, G, bx);
        EpiProj E{PROJ, (const float*)(ws + WS_ROPE)};
        pg8::gemm_phase<EpiProj, pg8::DenseOrder, true>(lds, 1024, S, E);
    }
    SEAM(1);
    if (IN(2)) {
        REPS(13) { for (int u = (wave >> 1) * G + vcu; u < 1024; u += 4 * G) gla_a_wave(a, lds + wave * 16384, u, wave & 1, lane); __syncthreads(); }
        float lam;
        { const float p1 = wave_sum(a.lam_q1[lane] * a.lam_k1[lane]), p2 = wave_sum(a.lam_q2[lane] * a.lam_k2[lane]); lam = expf(p1) - expf(p2) + LAM_INIT; }
        for (int pass = ((REP_MASK >> 2) & 1) ? 0 : 1; pass < 2; ++pass) {
            bf16* obase = pass ? PROJ + C_DQ : (bf16*)a.out; const int opitch = pass ? NPROJ : 512;
            for (int p = vcu; p < 256; p += G) {
                const int bh = p >> 3, jl = p & 7; float na1, na2, nb1, nb2, sg;
                attn_unit<1>(lds, PROJ, bh >> 2, bh & 3, 15 - jl, lam, a.subln_g, tid, obase, opitch, 0, na1, na2, sg);
                attn_unit<1>(lds, PROJ, bh >> 2, bh & 3, jl, lam, a.subln_g, tid, obase, opitch, 1, nb1, nb2, sg);
                attn_unit<2>(lds, PROJ, bh >> 2, bh & 3, 15 - jl, lam, a.subln_g, tid, obase, opitch, 0, na1, na2, sg);
                attn_unit<2>(lds, PROJ, bh >> 2, bh & 3, jl, lam, a.subln_g, tid, obase, opitch, 1, nb1, nb2, sg);
            }
        }
    }
    SEAM(2);
    if (IN(3)) REPS(3) {
        const bf16* DS = (const bf16*)(ws + WS_DS); bf16* SP = (bf16*)(ws + WS_SP); const float* DEC = (const float*)(ws + WS_DEC);
        for (int it = bx * 512 + tid; it < 32 * 64 * 64; it += G * 512) {
            const int bh = it >> 12, d = (it >> 6) & 63, ep = it & 63;
            float s0 = 0.f, s1 = 0.f;
#pragma unroll 4
            for (int n = 0; n < 32; ++n) {
                const size_t unit = (size_t)bh * 32 + n; const size_t idx = (unit * 64 + d) * 128 + 2 * ep;
                const unsigned dv = *(const unsigned*)(DS + idx); const float dc = DEC[unit * 64 + d];
                *(unsigned*)(SP + idx) = cvt_pk_bf16(s0, s1);
                s0 = dc * (s0 + bf_lo(dv)); s1 = dc * (s1 + bf_hi(dv));
            }
        }
    }
    SEAM(3);
    if (IN(4)) {
        for (int pass = ((REP_MASK >> 4) & 1) ? 0 : 1; pass < 2; ++pass)
            for (int u0 = vcu; u0 < 1024; u0 += 4 * G) { const int u = (wave >> 1) * G + u0;
                gla_c_wave(a, lds + (wave >> 1) * 32768, u < 1024 ? u : 0, wave & 1, u < 1024, lane, pass == 0); }
    }
    SEAM(4);
    if (IN(5)) REPS(5) {
        pg8::DenseOrder S; S.init(ws + WS_A, NPROJ, ws + WS_WO, 1024, T, D, G, bx);
        EpiPre1 E{a.out, a.x, (const float*)(ws + WS_STATS), a.ln_in_g, a.ln_in_b};
        pg8::gemm_phase<EpiPre1, pg8::DenseOrder, true>(lds, 1024, S, E);
    }
    SEAM(5);
    if (IN(6)) { for (int pass = ((REP_MASK >> 6) & 1) ? 0 : 1; pass < 2; ++pass) { phase6(a, lds, G, tid, lane, wave, pass == 0); __syncthreads(); } }
    SEAM(6);
    if (IN(7) || IN(8)) {
        LAS int* cntl = (LAS int*)(lds + LDSCTL_OFF + 64); LAS int* tst = (LAS int*)(lds + LDSCTL_OFF + 192);
        if (tid == 0) { int acc = 0; for (int e = 0; e < 32; ++e) { const int c = (int)__hip_atomic_load(ctl + CW_CNT + e, RLX_AGENT); cntl[e] = c; tst[e] = acc; acc += (c + 255) >> 8; } tst[32] = acc; }
        __syncthreads();
        if (IN(7)) REPS(7) {
            MoeOrder S{(const int*)cntl, (const int*)tst, (const char*)(ws + WS_HB), (const char*)(ws + WS_WGU), (const int*)(ws + WS_LTOK), 1024, 1024, G, bx, true, (size_t)1024 * 1024 * 2};
            EpiGU E{(bf16*)(ws + WS_B)};
            pg8::gemm_phase<EpiGU, MoeOrder, true>(lds, 1024, S, E);
        }
        SEAM(7);
        if (IN(8)) REPS(8) {
            MoeOrder S{(const int*)cntl, (const int*)tst, (const char*)(ws + WS_B), (const char*)(ws + WS_WD), (const int*)(ws + WS_LTOK), 512, 512, G, bx, false, (size_t)1024 * 512 * 2};
            EpiDown E{(bf16*)(ws + WS_Y), (const int*)(ws + WS_LTOK), (const float*)(ws + WS_LW)};
            pg8::gemm_phase<EpiDown, MoeOrder, true>(lds, 512, S, E);
        }
    }
    SEAM(8);
    if (IN(9)) REPS(9) {
        const bf16* HB = (const bf16*)(ws + WS_HB); const bf16* Y = (const bf16*)(ws + WS_Y);
        const int gw = vcu * 8 + wave, NGW = G * 8;
        f32x4 g4[4], b4[4];
#pragma unroll
        for (int j = 0; j < 4; ++j) { g4[j] = *(const f32x4*)(a.ln2_g + 4 * lane + 256 * j); b4[j] = *(const f32x4*)(a.ln2_b + 4 * lane + 256 * j); }
        const unsigned tmo = __hip_atomic_load(ctl + CW_BAR + XB_TMO, RLX_AGENT);
        for (int m = gw; m < T; m += NGW) {
            const GAS v2u* hp = (const GAS v2u*)(HB + (size_t)m * D) + lane; const GAS v2u* y0 = (const GAS v2u*)(Y + (size_t)m * 2 * D) + lane; const GAS v2u* y1 = y0 + 256;
            f32x4 v[4]; float s = 0.f;
#pragma unroll
            for (int j = 0; j < 4; ++j) { const v2u hw = hp[64 * j], ya = y0[64 * j], yb = y1[64 * j];
                v[j].x = ALPHA * bf_lo(hw.x) + bf_lo(ya.x) + bf_lo(yb.x); v[j].y = ALPHA * bf_hi(hw.x) + bf_hi(ya.x) + bf_hi(yb.x);
                v[j].z = ALPHA * bf_lo(hw.y) + bf_lo(ya.y) + bf_lo(yb.y); v[j].w = ALPHA * bf_hi(hw.y) + bf_hi(ya.y) + bf_hi(yb.y);
                s += (v[j].x + v[j].y) + (v[j].z + v[j].w); }
            const float mean = wave_sum(s) * (1.f / D); float s2 = 0.f;
#pragma unroll
            for (int j = 0; j < 4; ++j) { v[j] = v[j] - mean; s2 += (v[j].x * v[j].x + v[j].y * v[j].y) + (v[j].z * v[j].z + v[j].w * v[j].w); }
            float rstd = 1.f / sqrtf(wave_sum(s2) * (1.f / D) + LN_EPS);
            if (tmo) rstd = __builtin_nanf("");
            GAS f32x4* op = (GAS f32x4*)(a.out + (size_t)m * D) + lane;
#pragma unroll
            for (int j = 0; j < 4; ++j) op[64 * j] = v[j] * rstd * g4[j] + b4[j];
        }
    }
#undef IN
#undef SEAM
}

extern "C" void kernel_launch(void* const* d_in, const int* in_sizes, int n_in, void* d_out, int out_size, void* d_ws, size_t ws_size, hipStream_t stream) {
    static int grid = 0;
    if (grid == 0) {
        if (n_in != 25 || in_sizes[0] != T * D || out_size != T * D || ws_size < WS_END) { fprintf(stderr, "kernel_launch: unexpected shapes (n_in %d, in0 %d, out %d, ws %zu)\n", n_in, n_in > 0 ? in_sizes[0] : -1, out_size, ws_size); grid = -1; return; }
        int dev = 0, cus = 0, per_cu = 0;
        if (hipGetDevice(&dev) != hipSuccess || hipDeviceGetAttribute(&cus, hipDeviceAttributeMultiprocessorCount, dev) != hipSuccess) { grid = -1; return; }
        if (hipFuncSetAttribute((const void*)fwd_kernel, hipFuncAttributeMaxDynamicSharedMemorySize, LDS_BYTES) != hipSuccess) { fprintf(stderr, "kernel_launch: hipFuncSetAttribute failed\n"); grid = -1; return; }
        if (hipOccupancyMaxActiveBlocksPerMultiprocessor(&per_cu, (const void*)fwd_kernel, 512, LDS_BYTES) != hipSuccess || per_cu < 1) fprintf(stderr, "kernel_launch: occupancy query reports %d\n", per_cu);
        (void)hipGetLastError();
        grid = cus;
    }
    if (grid < 0) return;
    (void)hipMemsetAsync((char*)d_ws + WS_CTL, 0, CTL_ZERO_BYTES, stream);
    Args a{};
    a.x = (const float*)d_in[0]; a.pos = (const int*)d_in[1]; a.ln_in_g = (const float*)d_in[2]; a.ln_in_b = (const float*)d_in[3]; a.w_in = (const float*)d_in[4];
    a.lam_q1 = (const float*)d_in[5]; a.lam_k1 = (const float*)d_in[6]; a.lam_q2 = (const float*)d_in[7]; a.lam_k2 = (const float*)d_in[8]; a.subln_g = (const float*)d_in[9];
    a.wg2 = (const float*)d_in[10]; a.bg2 = (const float*)d_in[11]; a.gla_norm_g = (const float*)d_in[12]; a.w_o = (const float*)d_in[13]; a.ln1_g = (const float*)d_in[14]; a.ln1_b = (const float*)d_in[15];
    a.w_rg = (const float*)d_in[16]; a.b_rg = (const float*)d_in[17]; a.w_re = (const float*)d_in[18]; a.b_re = (const float*)d_in[19];
    a.w_gate = (const float*)d_in[20]; a.w_up = (const float*)d_in[21]; a.w_down = (const float*)d_in[22]; a.ln2_g = (const float*)d_in[23]; a.ln2_b = (const float*)d_in[24];
    a.out = (float*)d_out; a.ws = (unsigned char*)d_ws;
#if MK_SPLIT
    for (int p = 0; p < NPH; ++p) { a.ph_lo = p; a.ph_hi = p + 1; hipLaunchKernelGGL(fwd_kernel, dim3(grid), dim3(512), LDS_BYTES, stream, a); }
#else
    a.ph_lo = 0; a.ph_hi = NPH;
    hipLaunchKernelGGL(fwd_kernel, dim3(grid), dim3(512), LDS_BYTES, stream, a);
#endif
}
```
